# Optimizing an MI355X kernel written in HIP

```python
import jax, jax.numpy as jnp
from jax import lax
import numpy as np

D_MODEL = 1024
BATCH = 8
SEQ = 2048
DEPTH = 1
DEC_BATCH = 128
DEC_SEQ = 4
PAST_LEN = 16384
PAGE_SIZE = 128

N_META = 16
D_FF = 2816
CONV_A_WIDTH = 3
D_CONV_A = D_MODEL
SSM_EXPAND = 2
D_SSM = SSM_EXPAND * D_MODEL
SSM_HEAD_DIM = 64
SSM_HEADS = D_SSM // SSM_HEAD_DIM
SSM_GROUPS = 4
HEADS_PER_GROUP = SSM_HEADS // SSM_GROUPS
SSM_STATE = 128
SSM_CONV_WIDTH = 4
SSM_CHUNK = 128
D_XBC = D_SSM + 2 * SSM_GROUPS * SSM_STATE
PROJ_SPLITS = (D_CONV_A, D_CONV_A, D_CONV_A, D_SSM, D_XBC, SSM_HEADS, D_MODEL, D_MODEL)
D_IN_PROJ = 3 * D_CONV_A + D_SSM + D_XBC + SSM_HEADS + 2 * D_MODEL
EPS = 1e-6

kernel_name = "hybrid_shortconv_ssd_macaron_step"


def rmsnorm(x, w):
    xf = x.astype(jnp.float32)
    y = xf * lax.rsqrt(jnp.mean(xf * xf, axis=-1, keepdims=True) + EPS)
    return (y * w.astype(jnp.float32)).astype(x.dtype)


def swiglu(x, w_gu, w_down):
    g, u = jnp.split(x @ w_gu, 2, axis=-1)
    return (jax.nn.silu(g) * u) @ w_down


def causal_dwconv(x, buf, w):
    width = w.shape[0]
    seqlen = x.shape[1]
    xp = jnp.concatenate([buf.astype(x.dtype), x], axis=1)
    y = xp[:, 0:seqlen] * w[0]
    for k in range(1, width):
        y = y + xp[:, k:k + seqlen] * w[k]
    return y, xp[:, seqlen:]


def ssd_chunked(xh, dt, a, bm, cm, h0, chunk):
    b, l = xh.shape[:2]
    c = l // chunk
    x = xh.reshape(b, c, chunk, SSM_GROUPS, HEADS_PER_GROUP, SSM_HEAD_DIM)
    dtc = dt.reshape(b, c, chunk, SSM_GROUPS, HEADS_PER_GROUP)
    bc = bm.reshape(b, c, chunk, SSM_GROUPS, SSM_STATE)
    cc = cm.reshape(b, c, chunk, SSM_GROUPS, SSM_STATE)
    acs = jnp.cumsum(dtc * a.reshape(SSM_GROUPS, HEADS_PER_GROUP), axis=2)
    xdt = x * dtc[..., None]
    mask = jnp.tril(jnp.ones((chunk, chunk), dtype=bool))[:, :, None, None]
    seg = acs[:, :, :, None] - acs[:, :, None, :]
    lmat = jnp.exp(jnp.where(mask, seg, -jnp.inf))
    cb = jnp.einsum('bcqgn,bcsgn->bcqsg', cc, bc)
    y_diag = jnp.einsum('bcqsg,bcqsgr,bcsgrp->bcqgrp', cb, lmat, xdt)
    decay = jnp.exp(acs[:, :, -1:] - acs)
    states = jnp.einsum('bcsgn,bcsgr,bcsgrp->bcgrpn', bc, decay, xdt)
    chunk_decay = jnp.exp(acs[:, :, -1])
    h_init = h0.reshape(b, SSM_GROUPS, HEADS_PER_GROUP, SSM_HEAD_DIM, SSM_STATE)

    def step(h, inp):
        s, d = inp
        return h * d[..., None, None] + s, h

    h_last, h_prev = lax.scan(step, h_init, (jnp.swapaxes(states, 0, 1), jnp.swapaxes(chunk_decay, 0, 1)))
    h_prev = jnp.swapaxes(h_prev, 0, 1)
    y_off = jnp.einsum('bcqgn,bcgrpn,bcqgr->bcqgrp', cc, h_prev, jnp.exp(acs))
    y = (y_diag + y_off).reshape(b, l, SSM_HEADS, SSM_HEAD_DIM)
    return y, h_last.reshape(b, SSM_HEADS, SSM_HEAD_DIM, SSM_STATE)


def token_mix(u, buf_a, buf_ssm_conv, h_ssm, segments, w_in, conv_a_w, w_a_out,
              ssm_conv_w, ssm_conv_b, dt_bias, a_log, d_skip, ssm_norm_w, w_b_out, w_o):
    f32 = jnp.float32
    bsz, seqlen, _ = u.shape
    idx = np.cumsum(PROJ_SPLITS)[:-1].tolist()
    a_b, a_c, a_h, z, xbc, dt_raw, g_a, g_b = jnp.split(u @ w_in, idx, axis=-1)
    conv_a, new_buf_a = causal_dwconv(a_c * a_h, buf_a, conv_a_w)
    y_a = (a_b * conv_a) @ w_a_out
    xbc_c, new_buf_ssm = causal_dwconv(xbc, buf_ssm_conv, ssm_conv_w)
    xbc_c = jax.nn.silu(xbc_c + ssm_conv_b)
    xs, bm, cm = jnp.split(xbc_c, [D_SSM, D_SSM + SSM_GROUPS * SSM_STATE], axis=-1)
    xh = xs.astype(f32).reshape(bsz, seqlen, SSM_HEADS, SSM_HEAD_DIM)
    bm = bm.astype(f32).reshape(bsz, seqlen, SSM_GROUPS, SSM_STATE)
    cm = cm.astype(f32).reshape(bsz, seqlen, SSM_GROUPS, SSM_STATE)
    dt = jax.nn.softplus(dt_raw.astype(f32) + dt_bias.astype(f32))
    a = -jnp.exp(a_log.astype(f32))
    h = h_ssm.astype(f32)
    ys = []
    start = 0
    for seg_len, chunk in segments:
        y_seg, h = ssd_chunked(xh[:, start:start + seg_len], dt[:, start:start + seg_len], a,
                               bm[:, start:start + seg_len], cm[:, start:start + seg_len], h, chunk)
        ys.append(y_seg)
        start += seg_len
    y = jnp.concatenate(ys, axis=1) + d_skip.astype(f32)[:, None] * xh
    y = y.reshape(bsz, seqlen, D_SSM) * jax.nn.silu(z.astype(f32))
    yg = y.reshape(bsz, seqlen, SSM_GROUPS, D_SSM // SSM_GROUPS)
    yg = yg * lax.rsqrt(jnp.mean(yg * yg, axis=-1, keepdims=True) + EPS)
    y_b = (yg.reshape(bsz, seqlen, D_SSM) * ssm_norm_w.astype(f32)).astype(u.dtype) @ w_b_out
    merged = jax.nn.sigmoid(g_a) * y_a + jax.nn.sigmoid(g_b) * y_b
    return merged @ w_o, new_buf_a, new_buf_ssm, h.astype(h_ssm.dtype)


def run_trunk(x, bufs_a, bufs_ssm_conv, hs_ssm, segments, norm_ffn1, ffn1_w_gu, ffn1_w_down,
              norm_mix, w_in, conv_a_w, w_a_out, ssm_conv_w, ssm_conv_b, dt_bias, a_log,
              d_skip, ssm_norm_w, w_b_out, w_o, norm_ffn2, ffn2_w_gu, ffn2_w_down, norm_final):
    new_a, new_c, new_h = [], [], []
    h = x
    for i in range(DEPTH):
        h = h + 0.5 * swiglu(rmsnorm(h, norm_ffn1[i]), ffn1_w_gu[i], ffn1_w_down[i])
        m, ba, bc, hs = token_mix(rmsnorm(h, norm_mix[i]), bufs_a[i], bufs_ssm_conv[i], hs_ssm[i],
                                  segments, w_in[i], conv_a_w[i], w_a_out[i], ssm_conv_w[i],
                                  ssm_conv_b[i], dt_bias[i], a_log[i], d_skip[i], ssm_norm_w[i],
                                  w_b_out[i], w_o[i])
        h = h + m
        h = h + 0.5 * swiglu(rmsnorm(h, norm_ffn2[i]), ffn2_w_gu[i], ffn2_w_down[i])
        new_a.append(ba)
        new_c.append(bc)
        new_h.append(hs)
    return rmsnorm(h, norm_final), jnp.stack(new_a), jnp.stack(new_c), jnp.stack(new_h)


def setup_inputs(seed: int = 0) -> dict:
    key = jax.random.key(seed)
    ks = list(jax.random.split(key, 32))
    nrm = jax.random.normal
    f32 = jnp.float32

    def gain(k):
        return 1.0 + 0.01 * nrm(k, (DEPTH, D_MODEL), f32)

    dt0 = jnp.exp(jax.random.uniform(ks[20], (DEPTH, SSM_HEADS), f32, np.log(1e-3), np.log(1e-1)))
    return {
        "x_prompt": nrm(ks[0], (BATCH, SEQ, D_MODEL), f32),
        "x_sample": nrm(ks[1], (DEC_BATCH, DEC_SEQ, D_MODEL), f32),
        "state_conv_a": 0.5 * nrm(ks[2], (DEPTH, DEC_BATCH, CONV_A_WIDTH - 1, D_CONV_A), f32),
        "state_ssm_conv": nrm(ks[3], (DEPTH, DEC_BATCH, SSM_CONV_WIDTH - 1, D_XBC), f32),
        "state_ssm": 0.1 * nrm(ks[4], (DEPTH, DEC_BATCH, SSM_HEADS, SSM_HEAD_DIM, SSM_STATE), f32),
        "meta_tokens": nrm(ks[5], (N_META, D_MODEL), f32),
        "norm_ffn1": gain(ks[6]),
        "ffn1_w_gu": nrm(ks[7], (DEPTH, D_MODEL, 2 * D_FF), f32) * D_MODEL ** -0.5,
        "ffn1_w_down": nrm(ks[8], (DEPTH, D_FF, D_MODEL), f32) * D_FF ** -0.5,
        "norm_mix": gain(ks[9]),
        "w_in": nrm(ks[10], (DEPTH, D_MODEL, D_IN_PROJ), f32) * D_MODEL ** -0.5,
        "conv_a_w": nrm(ks[11], (DEPTH, CONV_A_WIDTH, D_CONV_A), f32) * CONV_A_WIDTH ** -0.5,
        "w_a_out": nrm(ks[12], (DEPTH, D_CONV_A, D_MODEL), f32) * D_CONV_A ** -0.5,
        "ssm_conv_w": nrm(ks[13], (DEPTH, SSM_CONV_WIDTH, D_XBC), f32) * SSM_CONV_WIDTH ** -0.5,
        "ssm_conv_b": 0.01 * nrm(ks[14], (DEPTH, D_XBC), f32),
        "dt_bias": dt0 + jnp.log(-jnp.expm1(-dt0)),
        "a_log": jnp.log(jax.random.uniform(ks[15], (DEPTH, SSM_HEADS), f32, 1.0, 16.0)),
        "d_skip": 1.0 + 0.01 * nrm(ks[16], (DEPTH, SSM_HEADS), f32),
        "ssm_norm_w": 1.0 + 0.01 * nrm(ks[17], (DEPTH, D_SSM), f32),
        "w_b_out": nrm(ks[18], (DEPTH, D_SSM, D_MODEL), f32) * D_SSM ** -0.5,
        "w_o": nrm(ks[19], (DEPTH, D_MODEL, D_MODEL), f32) * D_MODEL ** -0.5,
        "norm_ffn2": gain(ks[21]),
        "ffn2_w_gu": nrm(ks[22], (DEPTH, D_MODEL, 2 * D_FF), f32) * D_MODEL ** -0.5,
        "ffn2_w_down": nrm(ks[23], (DEPTH, D_FF, D_MODEL), f32) * D_FF ** -0.5,
        "norm_final": 1.0 + 0.01 * nrm(ks[24], (D_MODEL,), f32),
    }


def reference(x_prompt, x_sample, state_conv_a, state_ssm_conv, state_ssm, meta_tokens,
              norm_ffn1, ffn1_w_gu, ffn1_w_down, norm_mix, w_in, conv_a_w, w_a_out,
              ssm_conv_w, ssm_conv_b, dt_bias, a_log, d_skip, ssm_norm_w, w_b_out, w_o,
              norm_ffn2, ffn2_w_gu, ffn2_w_down, norm_final):
    weights = (norm_ffn1, ffn1_w_gu, ffn1_w_down, norm_mix, w_in, conv_a_w, w_a_out,
               ssm_conv_w, ssm_conv_b, dt_bias, a_log, d_skip, ssm_norm_w, w_b_out, w_o,
               norm_ffn2, ffn2_w_gu, ffn2_w_down, norm_final)
    bsz = x_prompt.shape[0]
    dt_p = x_prompt.dtype
    meta = jnp.broadcast_to(meta_tokens.astype(dt_p)[None], (bsz, N_META, D_MODEL))
    xp = jnp.concatenate([meta, x_prompt], axis=1)
    z_a = jnp.zeros((DEPTH, bsz, CONV_A_WIDTH - 1, D_CONV_A), dt_p)
    z_c = jnp.zeros((DEPTH, bsz, SSM_CONV_WIDTH - 1, D_XBC), dt_p)
    z_h = jnp.zeros((DEPTH, bsz, SSM_HEADS, SSM_HEAD_DIM, SSM_STATE), dt_p)
    seg_prompt = ((N_META, N_META), (x_prompt.shape[1], SSM_CHUNK))
    yp, prompt_conv_a, prompt_ssm_conv, prompt_ssm = run_trunk(xp, z_a, z_c, z_h, seg_prompt, *weights)
    y_prompt = yp[:, N_META:]
    seg_sample = ((x_sample.shape[1], x_sample.shape[1]),)
    y_sample, sample_conv_a, sample_ssm_conv, sample_ssm = run_trunk(
        x_sample, state_conv_a, state_ssm_conv, state_ssm, seg_sample, *weights)
    return (y_prompt, y_sample, prompt_conv_a, prompt_ssm_conv, prompt_ssm,
            sample_conv_a, sample_ssm_conv, sample_ssm)
```

```cpp
#include <hip/hip_runtime.h>
#include <hip/hip_cooperative_groups.h>
#include <cstdio>
#include <cstdint>
namespace cg = cooperative_groups;

typedef unsigned short bf16_t;
using bf16x8 = __attribute__((ext_vector_type(8))) short;
using f32x4 = __attribute__((ext_vector_type(4))) float;
#define DI __device__ __forceinline__
#define MFMA16(a, b, c) __builtin_amdgcn_mfma_f32_16x16x32_bf16((a), (b), (c), 0, 0, 0)

constexpr int MP = 16512, MS = 512, MTOT = 17024, LP = 2064;
constexpr int DM = 1024, DFF = 2816, DSSM = 2048, DXBC = 3072, NIN = 10368;
constexpr float EPS = 1e-6f;
constexpr int LDS_BYTES = 81920;
constexpr int NTHREADS = 256;
constexpr size_t OFF_YP = 0;
constexpr size_t OFF_YS = OFF_YP + (size_t)8 * 2048 * 1024;
constexpr size_t OFF_PCA = OFF_YS + (size_t)128 * 4 * 1024;
constexpr size_t OFF_PSC = OFF_PCA + (size_t)8 * 2 * 1024;
constexpr size_t OFF_PS = OFF_PSC + (size_t)8 * 3 * 3072;
constexpr size_t OFF_SCA = OFF_PS + (size_t)8 * 32 * 64 * 128;
constexpr size_t OFF_SSC = OFF_SCA + (size_t)128 * 2 * 1024;
constexpr size_t OFF_SS = OFF_SSC + (size_t)128 * 3 * 3072;

struct Params {
  const float *x_prompt, *x_sample, *st_conv_a, *st_ssm_conv, *st_ssm, *meta;
  const float *norm_ffn1, *w_gu1, *w_down1, *norm_mix, *w_in, *conv_a_w, *w_a_out, *ssm_conv_w, *ssm_conv_b, *dt_bias, *a_log,
      *d_skip, *ssm_norm_w, *w_b_out, *w_o, *norm_ffn2, *w_gu2, *w_down2, *norm_final;
  float* out;
  bf16_t *wt_gu1, *wt_down1, *wt_in, *wt_aout, *wt_bout, *wt_o, *wt_gu2, *wt_down2;
  bf16_t *R0;
  bf16_t *R1;
  bf16_t *AB;
  bf16_t *CH, *XBC, *SGA, *SGB;
  float *H, *DT, *ss0, *ssp, *ssq;
  int* counter;
};

DI unsigned short f2bf(float f) {
  unsigned u = __float_as_uint(f);
  u += 0x7fffu + ((u >> 16) & 1u);
  return (unsigned short)(u >> 16);
}
DI float bf2f(unsigned short b) { return __uint_as_float(((unsigned)b) << 16); }
DI unsigned pack2(float a, float b) { return (unsigned)f2bf(a) | ((unsigned)f2bf(b) << 16); }
DI float bflo(unsigned u) { return __uint_as_float(u << 16); }
DI float bfhi(unsigned u) { return __uint_as_float(u & 0xffff0000u); }
DI float sigmoidf_(float x) { return 1.f / (1.f + __expf(-x)); }
DI float siluf_(float x) { return x / (1.f + __expf(-x)); }

DI const float* xrow(const Params& p, int row) {
  if (row < MP) {
    int b = row / LP, t = row - b * LP;
    return t < 16 ? p.meta + (size_t)t * DM : p.x_prompt + ((size_t)b * 2048 + (t - 16)) * DM;
  }
  return p.x_sample + (size_t)(row - MP) * DM;
}

DI int colmap(int mode, int n) {
  if (mode == 0) return n;
  int tile = n >> 7, s = (n >> 4) & 7, i = n & 15;
  int oc = tile * 64 + (s >> 1) * 16 + i;
  if (mode == 1) return (s & 1) * DFF + oc;
  if (n < 2048) return (s & 1) ? 2048 + oc : 1024 + oc;
  if (n < 3072) return n - 2048;
  if (n < 8192) return n;
  if (n < 10240) return n + 32;
  if (n < 10272) return n - 2048;
  return -1;
}

DI void convert_weight(const float* __restrict__ src, const float* __restrict__ kscale, bf16_t* __restrict__ dst, int K, int Nsrc,
                               int Ndst, int mode, char* smem) {
  float* tile = (float*)smem;
  const int tid = threadIdx.x;
  const int kt_n = K >> 6;
  const int ntiles = (Ndst >> 6) * kt_n;
  for (int t = blockIdx.x; t < ntiles; t += gridDim.x) {
    const int n0 = (t / kt_n) << 6, k0 = (t % kt_n) << 6;
    {
      const int i = tid & 63, j0 = tid >> 6;
      const int sc = colmap(mode, n0 + i);
#pragma unroll
      for (int jj = 0; jj < 16; ++jj) {
        const int k = j0 * 16 + jj;
        float v = sc >= 0 ? src[(size_t)(k0 + k) * Nsrc + sc] : 0.f;
        tile[k * 65 + i] = v;
      }
    }
    __syncthreads();
    {
      const int kk = tid & 63, r0 = tid >> 6;
      const float ks = kscale ? kscale[k0 + kk] : 1.f;
#pragma unroll
      for (int rr = 0; rr < 16; ++rr) {
        const int r = r0 * 16 + rr;
        dst[(size_t)(n0 + r) * K + k0 + kk] = f2bf(tile[kk * 65 + r] * ks);
      }
    }
    __syncthreads();
  }
}

constexpr int LDT = 72;
constexpr int TILE_ELEMS = 128 * LDT;
constexpr int RS_OFF = 4 * TILE_ELEMS * 2;

DI void gemm_tile(const bf16_t* __restrict__ A, int lda, const bf16_t* __restrict__ Bt, int ldb, int K, int row0, int col0, char* smem,
                  f32x4 (&acc)[4][4]) {
  bf16_t* sA0 = (bf16_t*)smem;
  bf16_t* sB0 = sA0 + TILE_ELEMS;
  const int tid = threadIdx.x;
  const int lane = tid & 63, wid = tid >> 6, wr = wid >> 1, wc = wid & 1;
  const int fr = lane & 15, fq = lane >> 4;
  const int lrow = tid >> 3, lk = (tid & 7) * 8;
  const bf16_t* Ag = A + (size_t)(row0 + lrow) * lda + lk;
  const bf16_t* Bg = Bt + (size_t)(col0 + lrow) * ldb + lk;
  uint4 ra[4], rb[4];
#pragma unroll
  for (int i = 0; i < 4; ++i) {
    ra[i] = *(const uint4*)(Ag + (size_t)i * 32 * lda);
    rb[i] = *(const uint4*)(Bg + (size_t)i * 32 * ldb);
  }
#pragma unroll
  for (int i = 0; i < 4; ++i) {
    *(uint4*)(sA0 + (lrow + 32 * i) * LDT + lk) = ra[i];
    *(uint4*)(sB0 + (lrow + 32 * i) * LDT + lk) = rb[i];
  }
  __syncthreads();
  const int nk = K >> 6;
  for (int kt = 0; kt < nk; ++kt) {
    const int cur = kt & 1;
    const bf16_t* cA = sA0 + cur * 2 * TILE_ELEMS;
    const bf16_t* cB = cA + TILE_ELEMS;
    const bool more = (kt + 1 < nk);
    if (more) {
#pragma unroll
      for (int i = 0; i < 4; ++i) {
        ra[i] = *(const uint4*)(Ag + (size_t)i * 32 * lda + (kt + 1) * 64);
        rb[i] = *(const uint4*)(Bg + (size_t)i * 32 * ldb + (kt + 1) * 64);
      }
    }
#pragma unroll
    for (int ks = 0; ks < 2; ++ks) {
      bf16x8 af[4], bfr[4];
#pragma unroll
      for (int m = 0; m < 4; ++m) af[m] = *(const bf16x8*)(cA + (wr * 64 + m * 16 + fr) * LDT + ks * 32 + fq * 8);
#pragma unroll
      for (int n = 0; n < 4; ++n) bfr[n] = *(const bf16x8*)(cB + (wc * 64 + n * 16 + fr) * LDT + ks * 32 + fq * 8);
#pragma unroll
      for (int m = 0; m < 4; ++m)
#pragma unroll
        for (int n = 0; n < 4; ++n) acc[m][n] = MFMA16(af[m], bfr[n], acc[m][n]);
    }
    if (more) {
      bf16_t* nA = sA0 + (cur ^ 1) * 2 * TILE_ELEMS;
      bf16_t* nB = nA + TILE_ELEMS;
#pragma unroll
      for (int i = 0; i < 4; ++i) {
        *(uint4*)(nA + (lrow + 32 * i) * LDT + lk) = ra[i];
        *(uint4*)(nB + (lrow + 32 * i) * LDT + lk) = rb[i];
      }
    }
    __syncthreads();
  }
}

DI void zero_acc(f32x4 (&acc)[4][4]) {
#pragma unroll
  for (int m = 0; m < 4; ++m)
#pragma unroll
    for (int n = 0; n < 4; ++n) acc[m][n] = f32x4{0.f, 0.f, 0.f, 0.f};
}

DI void tile_coords(int t, int MT, int NT, int& mt, int& nt) {
  const int per = 8 * NT;
  const int mg = t / per, r = t - mg * per;
  const int gs = (MT - mg * 8) < 8 ? (MT - mg * 8) : 8;
  nt = r / gs;
  mt = mg * 8 + (r - nt * gs);
}

DI float sum16(float v) {
  v += __shfl_xor(v, 1);
  v += __shfl_xor(v, 2);
  v += __shfl_xor(v, 4);
  v += __shfl_xor(v, 8);
  return v;
}

DI void load_rs(const float* __restrict__ ssp, int nparts, int row0, char* smem) {
  float* s_rs = (float*)(smem + RS_OFF);
  const int tid = threadIdx.x;
  if (tid < 128) {
    float s = 0.f;
    for (int i = 0; i < nparts; ++i) s += ssp[(size_t)(row0 + tid) * nparts + i];
    s_rs[tid] = rsqrtf(s * (1.f / DM) + EPS);
  }
}

constexpr int MT = MTOT / 128;

DI void phase_ffn_up(const Params& p, const bf16_t* A, const bf16_t* Wt, const float* ssp, int nparts, bf16_t* ACT, char* smem) {
  const int NT = 2 * DFF / 128;
  const int tid = threadIdx.x, lane = tid & 63, wid = tid >> 6, wr = wid >> 1, wc = wid & 1, fr = lane & 15, fq = lane >> 4;
  const float* s_rs = (const float*)(smem + RS_OFF);
  for (int t = blockIdx.x; t < MT * NT; t += gridDim.x) {
    int mt, nt;
    tile_coords(t, MT, NT, mt, nt);
    const int row0 = mt * 128, col0 = nt * 128;
    __syncthreads();
    load_rs(ssp, nparts, row0, smem);
    f32x4 acc[4][4];
    zero_acc(acc);
    gemm_tile(A, DM, Wt, DM, DM, row0, col0, smem, acc);
#pragma unroll
    for (int m = 0; m < 4; ++m)
#pragma unroll
      for (int j = 0; j < 4; ++j) {
        const int r = wr * 64 + m * 16 + fq * 4 + j;
        const float rs = s_rs[r];
        const size_t row = row0 + r;
#pragma unroll
        for (int np = 0; np < 2; ++np) {
          const float g = acc[m][2 * np][j] * rs, u = acc[m][2 * np + 1][j] * rs;
          ACT[row * DFF + nt * 64 + (wc * 2 + np) * 16 + fr] = f2bf(siluf_(g) * u);
        }
      }
  }
}

DI void phase_down(const Params& p, const bf16_t* A, int K, const bf16_t* Wt, bool resid_from_x, float scale, bf16_t* HB, float* sspo, char* smem) {
  const int NT = DM / 128;
  const int tid = threadIdx.x, lane = tid & 63, wid = tid >> 6, wr = wid >> 1, wc = wid & 1, fr = lane & 15, fq = lane >> 4;
  for (int t = blockIdx.x; t < MT * NT; t += gridDim.x) {
    int mt, nt;
    tile_coords(t, MT, NT, mt, nt);
    const int row0 = mt * 128, col0 = nt * 128;
    f32x4 acc[4][4];
    zero_acc(acc);
    gemm_tile(A, K, Wt, K, K, row0, col0, smem, acc);
#pragma unroll
    for (int m = 0; m < 4; ++m)
#pragma unroll
      for (int j = 0; j < 4; ++j) {
        const int row = row0 + wr * 64 + m * 16 + fq * 4 + j;
        const float* res = resid_from_x ? xrow(p, row) : p.H + (size_t)row * DM;
        float part = 0.f;
#pragma unroll
        for (int n = 0; n < 4; ++n) {
          const int col = col0 + wc * 64 + n * 16 + fr;
          const float h = res[col] + scale * acc[m][n][j];
          p.H[(size_t)row * DM + col] = h;
          if (HB) HB[(size_t)row * DM + col] = f2bf(h);
          part += h * h;
        }
        part = sum16(part);
        if (fr == 0) sspo[(size_t)row * 16 + nt * 2 + wc] = part;
      }
  }
}

DI void phase_inproj(const Params& p, char* smem) {
  const int NT = NIN / 128;
  const int tid = threadIdx.x, lane = tid & 63, wid = tid >> 6, wr = wid >> 1, wc = wid & 1, fr = lane & 15, fq = lane >> 4;
  const float* s_rs = (const float*)(smem + RS_OFF);
  const bf16_t* A = p.R1;
  bf16_t* Z = p.R0;
  for (int t = blockIdx.x; t < MT * NT; t += gridDim.x) {
    int mt, nt;
    tile_coords(t, MT, NT, mt, nt);
    const int row0 = mt * 128, col0 = nt * 128;
    __syncthreads();
    load_rs(p.ssp, 16, row0, smem);
    f32x4 acc[4][4];
    zero_acc(acc);
    gemm_tile(A, DM, p.wt_in, DM, DM, row0, col0, smem, acc);
#pragma unroll
    for (int m = 0; m < 4; ++m)
#pragma unroll
      for (int j = 0; j < 4; ++j) {
        const int r = wr * 64 + m * 16 + fq * 4 + j;
        const float rs = s_rs[r];
        const int row = row0 + r;
        int b, tt;
        bool samp = row >= MP;
        if (!samp) { b = row / LP; tt = row - b * LP; } else { b = (row - MP) >> 2; tt = (row - MP) & 3; }
        if (nt < 16) {
          int idx = samp ? tt - 2 : tt - (LP - 2);
          float* so = p.out + (samp ? OFF_SCA : OFF_PCA) + ((size_t)b * 2 + idx) * 1024;
#pragma unroll
          for (int np = 0; np < 2; ++np) {
            const float v = (acc[m][2 * np][j] * rs) * (acc[m][2 * np + 1][j] * rs);
            const int col = nt * 64 + (wc * 2 + np) * 16 + fr;
            p.CH[(size_t)row * DM + col] = f2bf(v);
            if (idx >= 0) so[col] = v;
          }
        } else if (nt < 24) {
#pragma unroll
          for (int n = 0; n < 4; ++n) {
            const int col = (nt - 16) * 128 + wc * 64 + n * 16 + fr;
            p.AB[(size_t)row * DM + col] = f2bf(acc[m][n][j] * rs);
          }
        } else if (nt < 40) {
#pragma unroll
          for (int n = 0; n < 4; ++n) {
            const int col = (nt - 24) * 128 + wc * 64 + n * 16 + fr;
            Z[(size_t)row * DSSM + col] = f2bf(acc[m][n][j] * rs);
          }
        } else if (nt < 64) {
          int idx = samp ? tt - 1 : tt - (LP - 3);
          float* so = p.out + (samp ? OFF_SSC : OFF_PSC) + ((size_t)b * 3 + idx) * DXBC;
#pragma unroll
          for (int n = 0; n < 4; ++n) {
            const int col = (nt - 40) * 128 + wc * 64 + n * 16 + fr;
            const float v = acc[m][n][j] * rs;
            p.XBC[(size_t)row * DXBC + col] = f2bf(v);
            if (idx >= 0) so[col] = v;
          }
        } else if (nt < 72) {
#pragma unroll
          for (int n = 0; n < 4; ++n) {
            const int col = (nt - 64) * 128 + wc * 64 + n * 16 + fr;
            p.SGA[(size_t)row * DM + col] = f2bf(sigmoidf_(acc[m][n][j] * rs));
          }
        } else if (nt < 80) {
#pragma unroll
          for (int n = 0; n < 4; ++n) {
            const int col = (nt - 72) * 128 + wc * 64 + n * 16 + fr;
            p.SGB[(size_t)row * DM + col] = f2bf(sigmoidf_(acc[m][n][j] * rs));
          }
        } else {
          if (wc == 0) {
#pragma unroll
            for (int n = 0; n < 2; ++n) {
              const int c = n * 16 + fr;
              const float v = acc[m][n][j] * rs + p.dt_bias[c];
              p.DT[(size_t)row * 32 + c] = v > 20.f ? v : log1pf(__expf(v));
            }
          }
        }
      }
  }
}

DI void phase_merge(const Params& p, char* smem) {
  const int NT = DM / 128;
  const int tid = threadIdx.x, lane = tid & 63, wid = tid >> 6, wr = wid >> 1, wc = wid & 1, fr = lane & 15, fq = lane >> 4;
  const bf16_t* UA = p.R1;
  const bf16_t* YN = p.R0;
  bf16_t* MERGED = p.AB;
  for (int t = blockIdx.x; t < MT * NT; t += gridDim.x) {
    int mt, nt;
    tile_coords(t, MT, NT, mt, nt);
    const int row0 = mt * 128, col0 = nt * 128;
    f32x4 acc[4][4];
    zero_acc(acc);
    gemm_tile(UA, DM, p.wt_aout, DM, DM, row0, col0, smem, acc);
#pragma unroll
    for (int m = 0; m < 4; ++m)
#pragma unroll
      for (int n = 0; n < 4; ++n)
#pragma unroll
        for (int j = 0; j < 4; ++j) {
          const size_t row = row0 + wr * 64 + m * 16 + fq * 4 + j;
          const int col = col0 + wc * 64 + n * 16 + fr;
          MERGED[row * DM + col] = f2bf(acc[m][n][j] * bf2f(p.SGA[row * DM + col]));
        }
    zero_acc(acc);
    gemm_tile(YN, DSSM, p.wt_bout, DSSM, DSSM, row0, col0, smem, acc);
#pragma unroll
    for (int m = 0; m < 4; ++m)
#pragma unroll
      for (int n = 0; n < 4; ++n)
#pragma unroll
        for (int j = 0; j < 4; ++j) {
          const size_t row = row0 + wr * 64 + m * 16 + fq * 4 + j;
          const int col = col0 + wc * 64 + n * 16 + fr;
          const float mv = bf2f(MERGED[row * DM + col]);
          MERGED[row * DM + col] = f2bf(mv + acc[m][n][j] * bf2f(p.SGB[row * DM + col]));
        }
  }
}

constexpr int SC_OFF = 0, SB_OFF = 17408, SXT_OFF = 34816, SH_OFF = 44032, SG_OFF = 61440, SW_OFF = 70656, SDT_OFF = 77056, SACS_OFF = 77312,
              SWT_OFF = 77568, SITEM_OFF = 77824;
constexpr int LDN = 136;
constexpr int LDQ = 72;

DI void ssm_conv8(const Params& p, const float* sW, int cl8, int gch, int rowbase, int b, int t, bool samp, bool valid, float (&o)[8]) {
  if (!valid) {
#pragma unroll
    for (int e = 0; e < 8; ++e) o[e] = 0.f;
    return;
  }
#pragma unroll
  for (int e = 0; e < 8; ++e) o[e] = sW[4 * 320 + cl8 + e];
#pragma unroll
  for (int k = 0; k < 4; ++k) {
    const int tt = t - 3 + k;
    float v[8];
    if (tt >= 0) {
      const uint4 u = *(const uint4*)(p.XBC + (size_t)(rowbase + tt) * DXBC + gch);
      v[0] = bflo(u.x); v[1] = bfhi(u.x); v[2] = bflo(u.y); v[3] = bfhi(u.y);
      v[4] = bflo(u.z); v[5] = bfhi(u.z); v[6] = bflo(u.w); v[7] = bfhi(u.w);
    } else if (samp) {
      const float* hp = p.st_ssm_conv + ((size_t)b * 3 + (tt + 3)) * DXBC + gch;
      const float4 a0 = *(const float4*)hp, a1 = *(const float4*)(hp + 4);
      v[0] = a0.x; v[1] = a0.y; v[2] = a0.z; v[3] = a0.w; v[4] = a1.x; v[5] = a1.y; v[6] = a1.z; v[7] = a1.w;
    } else {
#pragma unroll
      for (int e = 0; e < 8; ++e) v[e] = 0.f;
    }
#pragma unroll
    for (int e = 0; e < 8; ++e) o[e] += sW[k * 320 + cl8 + e] * v[e];
  }
#pragma unroll
  for (int e = 0; e < 8; ++e) o[e] = siluf_(o[e]);
}

DI void ssd_item(const Params& p, int item, char* smem) {
  const int tid = threadIdx.x, lane = tid & 63, w = tid >> 6, fr = lane & 15, fq = lane >> 4;
  bf16_t* sC = (bf16_t*)(smem + SC_OFF);
  bf16_t* sB = (bf16_t*)(smem + SB_OFF);
  bf16_t* sXT = (bf16_t*)(smem + SXT_OFF);
  bf16_t* sH = (bf16_t*)(smem + SH_OFF);
  bf16_t* sG = (bf16_t*)(smem + SG_OFF);
  float* sW = (float*)(smem + SW_OFF);
  float* s_dt = (float*)(smem + SDT_OFF);
  float* s_acs = (float*)(smem + SACS_OFF);
  float* s_wt = (float*)(smem + SWT_OFF);

  const bool samp = item >= 256;
  int b, h, L, off, rowbase, nchunks;
  if (!samp) { b = item >> 5; h = item & 31; L = LP; off = 48; rowbase = b * LP; nchunks = 33; }
  else { const int it = item - 256; b = it >> 5; h = it & 31; L = 4; off = 0; rowbase = MP + b * 4; nchunks = 1; }
  const int g = h >> 3;
  const float a = -__expf(p.a_log[h]);
  const float Dh = p.d_skip[h];

  __syncthreads();
  for (int idx = tid; idx < 5 * 320; idx += NTHREADS) {
    const int k = idx / 320, c = idx - k * 320;
    const int ch = c < 64 ? h * 64 + c : (c < 192 ? 2048 + g * 128 + (c - 64) : 2560 + g * 128 + (c - 192));
    sW[idx] = k < 4 ? p.ssm_conv_w[k * DXBC + ch] : p.ssm_conv_b[ch];
  }
  f32x4 hacc[4][2];
  float* st_out = p.out + (samp ? OFF_SS : OFF_PS) + ((size_t)b * 32 + h) * 64 * 128;
  if (samp) {
    const float* st_in = p.st_ssm + ((size_t)b * 32 + h) * 64 * 128;
#pragma unroll
    for (int m = 0; m < 4; ++m)
#pragma unroll
      for (int nn = 0; nn < 2; ++nn)
#pragma unroll
        for (int j = 0; j < 4; ++j) hacc[m][nn][j] = st_in[(m * 16 + fq * 4 + j) * 128 + w * 32 + nn * 16 + fr];
  } else {
#pragma unroll
    for (int m = 0; m < 4; ++m)
#pragma unroll
      for (int nn = 0; nn < 2; ++nn) hacc[m][nn] = f32x4{0.f, 0.f, 0.f, 0.f};
  }
#pragma unroll
  for (int m = 0; m < 4; ++m)
#pragma unroll
    for (int nn = 0; nn < 2; ++nn)
#pragma unroll
      for (int j = 0; j < 4; ++j) sH[(m * 16 + fq * 4 + j) * LDN + w * 32 + nn * 16 + fr] = f2bf(hacc[m][nn][j]);

  for (int c = 0; c < nchunks; ++c) {
    __syncthreads();
    const int tbase = c * 64 - off;
    if (w == 0) {
      const int t = tbase + lane;
      const bool valid = t >= 0 && t < L;
      const float dtv = valid ? p.DT[(size_t)(rowbase + t) * 32 + h] : 0.f;
      float sc = dtv * a;
#pragma unroll
      for (int d = 1; d < 64; d <<= 1) {
        const float o = __shfl_up(sc, d);
        if (lane >= d) sc += o;
      }
      const float total = __shfl(sc, 63);
      s_dt[lane] = dtv;
      s_acs[lane] = sc;
      s_wt[lane] = dtv * __expf(total - sc);
    }
    {
      const int cc = tid & 7;
#pragma unroll
      for (int u = 0; u < 2; ++u) {
        const int i = (tid >> 3) + 32 * u;
        const int t = tbase + i;
        float o[8];
        ssm_conv8(p, sW, cc * 8, h * 64 + cc * 8, rowbase, b, t, samp, t >= 0 && t < L, o);
#pragma unroll
        for (int e = 0; e < 8; ++e) sXT[(cc * 8 + e) * LDQ + i] = f2bf(o[e]);
      }
      const int c16 = tid & 15;
#pragma unroll
      for (int u = 0; u < 4; ++u) {
        const int i = (tid >> 4) + 16 * u;
        const int t = tbase + i;
        const bool valid = t >= 0 && t < L;
        float o[8];
        ssm_conv8(p, sW, 64 + c16 * 8, 2048 + g * 128 + c16 * 8, rowbase, b, t, samp, valid, o);
        uint4 pk;
        pk.x = pack2(o[0], o[1]); pk.y = pack2(o[2], o[3]); pk.z = pack2(o[4], o[5]); pk.w = pack2(o[6], o[7]);
        *(uint4*)(sB + i * LDN + c16 * 8) = pk;
        ssm_conv8(p, sW, 192 + c16 * 8, 2560 + g * 128 + c16 * 8, rowbase, b, t, samp, valid, o);
        pk.x = pack2(o[0], o[1]); pk.y = pack2(o[2], o[3]); pk.z = pack2(o[4], o[5]); pk.w = pack2(o[6], o[7]);
        *(uint4*)(sC + i * LDN + c16 * 8) = pk;
      }
    }
    __syncthreads();
    f32x4 cb[4], y[4];
#pragma unroll
    for (int n = 0; n < 4; ++n) { cb[n] = f32x4{0.f, 0.f, 0.f, 0.f}; y[n] = f32x4{0.f, 0.f, 0.f, 0.f}; }
#pragma unroll
    for (int ks = 0; ks < 4; ++ks) {
      const bf16x8 af = *(const bf16x8*)(sC + (w * 16 + fr) * LDN + ks * 32 + fq * 8);
#pragma unroll
      for (int n = 0; n < 4; ++n) {
        const bf16x8 bb = *(const bf16x8*)(sB + (n * 16 + fr) * LDN + ks * 32 + fq * 8);
        cb[n] = MFMA16(af, bb, cb[n]);
        const bf16x8 hh = *(const bf16x8*)(sH + (n * 16 + fr) * LDN + ks * 32 + fq * 8);
        y[n] = MFMA16(af, hh, y[n]);
      }
    }
#pragma unroll
    for (int j = 0; j < 4; ++j) {
      const int q = w * 16 + fq * 4 + j;
      const float aq = s_acs[q];
      const float eq = __expf(aq);
#pragma unroll
      for (int n = 0; n < 4; ++n) {
        const int s = n * 16 + fr;
        const float val = (s <= q) ? cb[n][j] * __expf(aq - s_acs[s]) * s_dt[s] : 0.f;
        sG[q * LDQ + s] = f2bf(val);
        y[n][j] *= eq;
      }
    }
    __syncthreads();
#pragma unroll
    for (int ks = 0; ks < 2; ++ks) {
      const bf16x8 af = *(const bf16x8*)(sG + (w * 16 + fr) * LDQ + ks * 32 + fq * 8);
#pragma unroll
      for (int n = 0; n < 4; ++n) {
        const bf16x8 bb = *(const bf16x8*)(sXT + (n * 16 + fr) * LDQ + ks * 32 + fq * 8);
        y[n] = MFMA16(af, bb, y[n]);
      }
    }
    {
      bf16_t* ZY = p.R0;
#pragma unroll
      for (int j = 0; j < 4; ++j) {
        const int q = w * 16 + fq * 4 + j;
        const int t = tbase + q;
        const bool valid = t >= 0 && t < L;
        const size_t row = (size_t)(rowbase + (valid ? t : 0));
        float part = 0.f;
#pragma unroll
        for (int n = 0; n < 4; ++n) {
          const int pch = n * 16 + fr;
          const float xv = bf2f(sXT[pch * LDQ + q]);
          float yv = y[n][j] + Dh * xv;
          const float zv = bf2f(ZY[row * DSSM + h * 64 + pch]);
          yv *= siluf_(zv);
          if (valid) ZY[row * DSSM + h * 64 + pch] = f2bf(yv);
          part += yv * yv;
        }
        part = sum16(part);
        if (fr == 0 && valid) p.ssq[row * 32 + h] = part;
      }
    }
    {
      const float cd = __expf(s_acs[63]);
#pragma unroll
      for (int m = 0; m < 4; ++m)
#pragma unroll
        for (int nn = 0; nn < 2; ++nn) hacc[m][nn] *= cd;
#pragma unroll
      for (int ks = 0; ks < 2; ++ks) {
        bf16x8 bfr[2];
#pragma unroll
        for (int nn = 0; nn < 2; ++nn) {
#pragma unroll
          for (int jj = 0; jj < 8; ++jj) {
            const int s = ks * 32 + fq * 8 + jj;
            const float bv = bf2f(sB[s * LDN + w * 32 + nn * 16 + fr]) * s_wt[s];
            bfr[nn][jj] = (short)f2bf(bv);
          }
        }
#pragma unroll
        for (int m = 0; m < 4; ++m) {
          const bf16x8 af = *(const bf16x8*)(sXT + (m * 16 + fr) * LDQ + ks * 32 + fq * 8);
#pragma unroll
          for (int nn = 0; nn < 2; ++nn) hacc[m][nn] = MFMA16(af, bfr[nn], hacc[m][nn]);
        }
      }
    }
    __syncthreads();
#pragma unroll
    for (int m = 0; m < 4; ++m)
#pragma unroll
      for (int nn = 0; nn < 2; ++nn)
#pragma unroll
        for (int j = 0; j < 4; ++j) sH[(m * 16 + fq * 4 + j) * LDN + w * 32 + nn * 16 + fr] = f2bf(hacc[m][nn][j]);
  }
#pragma unroll
  for (int m = 0; m < 4; ++m)
#pragma unroll
    for (int nn = 0; nn < 2; ++nn)
#pragma unroll
      for (int j = 0; j < 4; ++j) st_out[(m * 16 + fq * 4 + j) * 128 + w * 32 + nn * 16 + fr] = hacc[m][nn][j];
}

DI void phase_ssd(const Params& p, char* smem) {
  int* s_item = (int*)(smem + SITEM_OFF);
  const int nitems = 256 + 4096;
  while (true) {
    __syncthreads();
    if (threadIdx.x == 0) *s_item = atomicAdd(p.counter, 1);
    __syncthreads();
    const int item = *s_item;
    if (item >= nitems) break;
    ssd_item(p, item, smem);
  }
}

DI void phase_elementwise(const Params& p) {
  const size_t gt = (size_t)blockIdx.x * NTHREADS + threadIdx.x, gn = (size_t)gridDim.x * NTHREADS;
  bf16_t* Y = p.R0;
  for (size_t idx = gt; idx < (size_t)MTOT * 256; idx += gn) {
    const size_t row = idx >> 8;
    const int cc = (int)(idx & 255);
    const int g = cc >> 6;
    const float4 s0 = *(const float4*)(p.ssq + row * 32 + g * 8), s1 = *(const float4*)(p.ssq + row * 32 + g * 8 + 4);
    const float ss = s0.x + s0.y + s0.z + s0.w + s1.x + s1.y + s1.z + s1.w;
    const float rs = rsqrtf(ss * (1.f / 512.f) + EPS);
    uint4 u = *(const uint4*)(Y + row * DSSM + cc * 8);
    u.x = pack2(bflo(u.x) * rs, bfhi(u.x) * rs);
    u.y = pack2(bflo(u.y) * rs, bfhi(u.y) * rs);
    u.z = pack2(bflo(u.z) * rs, bfhi(u.z) * rs);
    u.w = pack2(bflo(u.w) * rs, bfhi(u.w) * rs);
    *(uint4*)(Y + row * DSSM + cc * 8) = u;
  }
  bf16_t* UA = p.R1;
  for (size_t idx = gt; idx < (size_t)MTOT * 128; idx += gn) {
    const int row = (int)(idx >> 7);
    const int c0 = (int)(idx & 127) * 8;
    int b, t;
    const bool samp = row >= MP;
    if (!samp) { b = row / LP; t = row - b * LP; } else { b = (row - MP) >> 2; t = (row - MP) & 3; }
    float conv[8];
#pragma unroll
    for (int e = 0; e < 8; ++e) conv[e] = 0.f;
#pragma unroll
    for (int k = 0; k < 3; ++k) {
      const int tt = t - 2 + k;
      float v[8];
      if (tt >= 0) {
        const uint4 u = *(const uint4*)(p.CH + (size_t)(row - 2 + k) * DM + c0);
        v[0] = bflo(u.x); v[1] = bfhi(u.x); v[2] = bflo(u.y); v[3] = bfhi(u.y);
        v[4] = bflo(u.z); v[5] = bfhi(u.z); v[6] = bflo(u.w); v[7] = bfhi(u.w);
      } else if (samp) {
        const float* hp = p.st_conv_a + ((size_t)b * 2 + (tt + 2)) * DM + c0;
        const float4 a0 = *(const float4*)hp, a1 = *(const float4*)(hp + 4);
        v[0] = a0.x; v[1] = a0.y; v[2] = a0.z; v[3] = a0.w; v[4] = a1.x; v[5] = a1.y; v[6] = a1.z; v[7] = a1.w;
      } else {
#pragma unroll
        for (int e = 0; e < 8; ++e) v[e] = 0.f;
      }
      const float4 w0 = *(const float4*)(p.conv_a_w + k * DM + c0), w1 = *(const float4*)(p.conv_a_w + k * DM + c0 + 4);
      conv[0] += w0.x * v[0]; conv[1] += w0.y * v[1]; conv[2] += w0.z * v[2]; conv[3] += w0.w * v[3];
      conv[4] += w1.x * v[4]; conv[5] += w1.y * v[5]; conv[6] += w1.z * v[6]; conv[7] += w1.w * v[7];
    }
    const uint4 ab = *(const uint4*)(p.AB + (size_t)row * DM + c0);
    uint4 o;
    o.x = pack2(bflo(ab.x) * conv[0], bfhi(ab.x) * conv[1]);
    o.y = pack2(bflo(ab.y) * conv[2], bfhi(ab.y) * conv[3]);
    o.z = pack2(bflo(ab.z) * conv[4], bfhi(ab.z) * conv[5]);
    o.w = pack2(bflo(ab.w) * conv[6], bfhi(ab.w) * conv[7]);
    *(uint4*)(UA + (size_t)row * DM + c0) = o;
  }
}

DI void phase_prep(const Params& p, char* smem) {
  if (blockIdx.x == 0 && threadIdx.x == 0) *p.counter = 0;
  const int lane = threadIdx.x & 63, wid = threadIdx.x >> 6;
  bf16_t* XB = p.R1;
  for (int row = blockIdx.x * 4 + wid; row < MTOT; row += gridDim.x * 4) {
    const float* xr = xrow(p, row);
    float ss = 0.f;
#pragma unroll
    for (int i = 0; i < 4; ++i) {
      const float4 v = *(const float4*)(xr + i * 256 + lane * 4);
      ss += v.x * v.x + v.y * v.y + v.z * v.z + v.w * v.w;
      uint2 o;
      o.x = pack2(v.x, v.y);
      o.y = pack2(v.z, v.w);
      *(uint2*)(XB + (size_t)row * DM + i * 256 + lane * 4) = o;
    }
#pragma unroll
    for (int d = 1; d < 64; d <<= 1) ss += __shfl_xor(ss, d);
    if (lane == 0) p.ss0[row] = ss;
  }
  convert_weight(p.w_gu1, p.norm_ffn1, p.wt_gu1, DM, 2 * DFF, 2 * DFF, 1, smem);
  convert_weight(p.w_down1, nullptr, p.wt_down1, DFF, DM, DM, 0, smem);
  convert_weight(p.w_in, p.norm_mix, p.wt_in, DM, 10272, NIN, 2, smem);
  convert_weight(p.w_a_out, nullptr, p.wt_aout, DM, DM, DM, 0, smem);
  convert_weight(p.w_b_out, p.ssm_norm_w, p.wt_bout, DSSM, DM, DM, 0, smem);
  convert_weight(p.w_o, nullptr, p.wt_o, DM, DM, DM, 0, smem);
  convert_weight(p.w_gu2, p.norm_ffn2, p.wt_gu2, DM, 2 * DFF, 2 * DFF, 1, smem);
  convert_weight(p.w_down2, nullptr, p.wt_down2, DFF, DM, DM, 0, smem);
}

DI void phase_final(const Params& p) {
  const int lane = threadIdx.x & 63, wid = threadIdx.x >> 6;
  for (int row = blockIdx.x * 4 + wid; row < MTOT; row += gridDim.x * 4) {
    float* o;
    if (row < MP) {
      const int b = row / LP, t = row - b * LP;
      if (t < 16) continue;
      o = p.out + OFF_YP + ((size_t)b * 2048 + (t - 16)) * DM;
    } else {
      o = p.out + OFF_YS + (size_t)(row - MP) * DM;
    }
    float s = 0.f;
    if (lane < 16) s = p.ssp[(size_t)row * 16 + lane];
    s = sum16(s);
    s = __shfl(s, 0);
    const float rs = rsqrtf(s * (1.f / DM) + EPS);
#pragma unroll
    for (int i = 0; i < 4; ++i) {
      const float4 v = *(const float4*)(p.H + (size_t)row * DM + i * 256 + lane * 4);
      const float4 wv = *(const float4*)(p.norm_final + i * 256 + lane * 4);
      float4 r;
      r.x = v.x * rs * wv.x; r.y = v.y * rs * wv.y; r.z = v.z * rs * wv.z; r.w = v.w * rs * wv.w;
      *(float4*)(o + i * 256 + lane * 4) = r;
    }
  }
}

__global__ void __launch_bounds__(NTHREADS, 2) hybrid_fwd(Params p) {
  extern __shared__ __attribute__((aligned(16))) char smem[];
  cg::grid_group grid = cg::this_grid();
  phase_prep(p, smem);
  grid.sync();
  phase_ffn_up(p, p.R1, p.wt_gu1, p.ss0, 1, p.R0, smem);
  grid.sync();
  phase_down(p, p.R0, DFF, p.wt_down1, true, 0.5f, p.R1, p.ssp, smem);
  grid.sync();
  phase_inproj(p, smem);
  grid.sync();
  phase_ssd(p, smem);
  grid.sync();
  phase_elementwise(p);
  grid.sync();
  phase_merge(p, smem);
  grid.sync();
  phase_down(p, p.AB, DM, p.wt_o, false, 1.0f, p.R1, p.ssp, smem);
  grid.sync();
  phase_ffn_up(p, p.R1, p.wt_gu2, p.ssp, 16, p.R0, smem);
  grid.sync();
  phase_down(p, p.R0, DFF, p.wt_down2, false, 0.5f, nullptr, p.ssp, smem);
  grid.sync();
  phase_final(p);
}

extern "C" void kernel_launch(void* const* d_in, const int* in_sizes, int n_in, void* d_out, int out_size, void* d_ws, size_t ws_size,
                              hipStream_t stream) {
  static int grid_blocks = 0;
  if (!grid_blocks) {
    int dev = 0, cus = 0, per_cu = 0;
    hipGetDevice(&dev);
    hipDeviceGetAttribute(&cus, hipDeviceAttributeMultiprocessorCount, dev);
    hipFuncSetAttribute((const void*)hybrid_fwd, hipFuncAttributeMaxDynamicSharedMemorySize, LDS_BYTES);
    hipOccupancyMaxActiveBlocksPerMultiprocessor(&per_cu, (const void*)hybrid_fwd, NTHREADS, LDS_BYTES);
    if (per_cu < 1) per_cu = 1;
    if (per_cu > 2) per_cu = 2;
    grid_blocks = cus * per_cu;
    fprintf(stderr, "kernel_launch: cus=%d per_cu=%d grid=%d ws=%zu\n", cus, per_cu, grid_blocks, ws_size);
  }
  Params p{};
  const float* const* in = (const float* const*)d_in;
  p.x_prompt = in[0]; p.x_sample = in[1]; p.st_conv_a = in[2]; p.st_ssm_conv = in[3]; p.st_ssm = in[4]; p.meta = in[5];
  p.norm_ffn1 = in[6]; p.w_gu1 = in[7]; p.w_down1 = in[8]; p.norm_mix = in[9]; p.w_in = in[10]; p.conv_a_w = in[11];
  p.w_a_out = in[12]; p.ssm_conv_w = in[13]; p.ssm_conv_b = in[14]; p.dt_bias = in[15]; p.a_log = in[16]; p.d_skip = in[17];
  p.ssm_norm_w = in[18]; p.w_b_out = in[19]; p.w_o = in[20]; p.norm_ffn2 = in[21]; p.w_gu2 = in[22]; p.w_down2 = in[23];
  p.norm_final = in[24];
  p.out = (float*)d_out;
  char* ws = (char*)d_ws;
  size_t off = 0;
  auto take = [&](size_t bytes) { char* r = ws + off; off += (bytes + 255) & ~(size_t)255; return r; };
  p.wt_gu1 = (bf16_t*)take((size_t)2 * DFF * DM * 2);
  p.wt_down1 = (bf16_t*)take((size_t)DM * DFF * 2);
  p.wt_in = (bf16_t*)take((size_t)NIN * DM * 2);
  p.wt_aout = (bf16_t*)take((size_t)DM * DM * 2);
  p.wt_bout = (bf16_t*)take((size_t)DM * DSSM * 2);
  p.wt_o = (bf16_t*)take((size_t)DM * DM * 2);
  p.wt_gu2 = (bf16_t*)take((size_t)2 * DFF * DM * 2);
  p.wt_down2 = (bf16_t*)take((size_t)DM * DFF * 2);
  p.R0 = (bf16_t*)take((size_t)MTOT * DFF * 2);
  p.R1 = (bf16_t*)take((size_t)MTOT * DM * 2);
  p.AB = (bf16_t*)take((size_t)MTOT * DM * 2);
  p.CH = (bf16_t*)take((size_t)MTOT * DM * 2);
  p.XBC = (bf16_t*)take((size_t)MTOT * DXBC * 2);
  p.SGA = (bf16_t*)take((size_t)MTOT * DM * 2);
  p.SGB = (bf16_t*)take((size_t)MTOT * DM * 2);
  p.H = (float*)take((size_t)MTOT * DM * 4);
  p.DT = (float*)take((size_t)MTOT * 32 * 4);
  p.ss0 = (float*)take((size_t)MTOT * 4);
  p.ssp = (float*)take((size_t)MTOT * 16 * 4);
  p.ssq = (float*)take((size_t)MTOT * 32 * 4);
  p.counter = (int*)take(256);
  if (off > ws_size) { fprintf(stderr, "kernel_launch: workspace too small: need %zu have %zu\n", off, ws_size); return; }
  void* args[] = {&p};
  hipError_t e = hipLaunchCooperativeKernel((const void*)hybrid_fwd, dim3(grid_blocks), dim3(NTHREADS), args, LDS_BYTES, stream);
  if (e != hipSuccess) fprintf(stderr, "cooperative launch failed: %s (grid %d)\n", hipGetErrorString(e), grid_blocks);
}
```

```cpp
#include <hip/hip_runtime.h>
#include <hip/hip_cooperative_groups.h>
#include <cstdio>
#include <cstdint>
namespace cg = cooperative_groups;

typedef unsigned short bf16_t;
using bf16x8 = __attribute__((ext_vector_type(8))) short;
using f32x4 = __attribute__((ext_vector_type(4))) float;
#define DI __device__ __forceinline__
#define MFMA16(a, b, c) __builtin_amdgcn_mfma_f32_16x16x32_bf16((a), (b), (c), 0, 0, 0)

constexpr int MP = 16512, MS = 512, MTOT = 17024, LP = 2064, MPAD = 17152;
constexpr int DM = 1024, DFF = 2816, DSSM = 2048, DXBC = 3072, NIN = 10496;
constexpr float EPS = 1e-6f;
constexpr int NTHREADS = 512;
constexpr int RS_LDS_OFF = 131072;
constexpr int SSD_HALF_BYTES = 71680;
constexpr int SITEM_OFF = 2 * SSD_HALF_BYTES;
constexpr int LDS_BYTES = SITEM_OFF + 1024;
constexpr size_t OFF_YP = 0;
constexpr size_t OFF_YS = OFF_YP + (size_t)8 * 2048 * 1024;
constexpr size_t OFF_PCA = OFF_YS + (size_t)128 * 4 * 1024;
constexpr size_t OFF_PSC = OFF_PCA + (size_t)8 * 2 * 1024;
constexpr size_t OFF_PS = OFF_PSC + (size_t)8 * 3 * 3072;
constexpr size_t OFF_SCA = OFF_PS + (size_t)8 * 32 * 64 * 128;
constexpr size_t OFF_SSC = OFF_SCA + (size_t)128 * 2 * 1024;
constexpr size_t OFF_SS = OFF_SSC + (size_t)128 * 3 * 3072;

struct Params {
  const float *x_prompt, *x_sample, *st_conv_a, *st_ssm_conv, *st_ssm, *meta;
  const float *norm_ffn1, *w_gu1, *w_down1, *norm_mix, *w_in, *conv_a_w, *w_a_out, *ssm_conv_w, *ssm_conv_b, *dt_bias, *a_log,
      *d_skip, *ssm_norm_w, *w_b_out, *w_o, *norm_ffn2, *w_gu2, *w_down2, *norm_final;
  float* out;
  char* ws;
};

constexpr size_t al256(size_t x) { return (x + 255) & ~(size_t)255; }
constexpr size_t O_wt_gu1 = 0;
constexpr size_t O_wt_down1 = O_wt_gu1 + al256((size_t)2 * DFF * DM * 2);
constexpr size_t O_wt_in = O_wt_down1 + al256((size_t)DM * DFF * 2);
constexpr size_t O_wt_aout = O_wt_in + al256((size_t)NIN * DM * 2);
constexpr size_t O_wt_bout = O_wt_aout + al256((size_t)DM * DM * 2);
constexpr size_t O_wt_o = O_wt_bout + al256((size_t)DM * DSSM * 2);
constexpr size_t O_wt_gu2 = O_wt_o + al256((size_t)DM * DM * 2);
constexpr size_t O_wt_down2 = O_wt_gu2 + al256((size_t)2 * DFF * DM * 2);
constexpr size_t O_R0 = O_wt_down2 + al256((size_t)DM * DFF * 2);
constexpr size_t O_R1 = O_R0 + al256((size_t)MPAD * DFF * 2);
constexpr size_t O_AB = O_R1 + al256((size_t)MPAD * DM * 2);
constexpr size_t O_CH = O_AB + al256((size_t)MPAD * DM * 2);
constexpr size_t O_XBC = O_CH + al256((size_t)MTOT * DM * 2);
constexpr size_t O_SGA = O_XBC + al256((size_t)MTOT * DXBC * 2);
constexpr size_t O_SGB = O_SGA + al256((size_t)MTOT * DM * 2);
constexpr size_t O_H = O_SGB + al256((size_t)MTOT * DM * 2);
constexpr size_t O_DT = O_H + al256((size_t)MTOT * DM * 4);
constexpr size_t O_ss0 = O_DT + al256((size_t)MTOT * 32 * 4);
constexpr size_t O_ssp = O_ss0 + al256((size_t)MTOT * 4);
constexpr size_t O_ssq = O_ssp + al256((size_t)MTOT * 16 * 4);
constexpr size_t O_rsv = O_ssq + al256((size_t)MTOT * 32 * 4);
constexpr size_t O_counter = O_rsv + al256((size_t)MTOT * 4);
constexpr size_t O_HALO = O_counter + 256;
constexpr size_t O_bar = O_HALO + al256((size_t)8 * 34 * 3 * DXBC * 2);
constexpr size_t BAR_BYTES = (3456 + 16 * 64) * 4;
constexpr size_t WS_END = O_bar + al256(BAR_BYTES);
#define WSB(p, name) ((bf16_t*)((p).ws + O_##name))
#define WSF(p, name) ((float*)((p).ws + O_##name))

typedef __bf16 bf16x2_t __attribute__((ext_vector_type(2)));
typedef float f32x2_t __attribute__((ext_vector_type(2)));
DI unsigned pack2(float a, float b) { f32x2_t v = {a, b}; bf16x2_t r = __builtin_convertvector(v, bf16x2_t); return __builtin_bit_cast(unsigned, r); }
DI unsigned short f2bf(float f) { return (unsigned short)(pack2(f, f) & 0xffffu); }
DI float bf2f(unsigned short b) { return __uint_as_float(((unsigned)b) << 16); }
DI float bflo(unsigned u) { return __uint_as_float(u << 16); }
DI float bfhi(unsigned u) { return __uint_as_float(u & 0xffff0000u); }
DI int opaque_tid() { int t = (int)threadIdx.x; asm volatile("" : "+v"(t)); return t; }
DI float fast_exp(float x) { return __builtin_amdgcn_exp2f(x * 1.44269504f); }
DI float sigmoidf_(float x) { return __builtin_amdgcn_rcpf(1.f + fast_exp(-x)); }
DI float siluf_(float x) { return x * __builtin_amdgcn_rcpf(1.f + fast_exp(-x)); }

DI const float* xrow_ptr(const float* x_prompt, const float* x_sample, const float* meta, int row) {
  if (row < MP) {
    int b = row / LP, t = row - b * LP;
    return t < 16 ? meta + (size_t)t * DM : x_prompt + ((size_t)b * 2048 + (t - 16)) * DM;
  }
  return x_sample + (size_t)(row - MP) * DM;
}

#define XB_TMO      128
#define XB_XCNT(j)  (256  + 64 * (j))
#define XB_XSUB(j)  (1280 + 64 * (j))
#define XB_XGEN(j)  (2304 + 64 * (j))
#define XB_TOP      3328
#define XB_TOPGEN   3392
#define XCD_BAR_WORDS 3456
#define XB_SPIN_CAP (1u << 18)
#define LAS __attribute__((address_space(3)))

__device__ __forceinline__ unsigned xb_ld(unsigned* p)              { return __hip_atomic_load(p, __ATOMIC_RELAXED, __HIP_MEMORY_SCOPE_AGENT); }
__device__ __forceinline__ unsigned xb_add(unsigned* p, unsigned v) { return __hip_atomic_fetch_add(p, v, __ATOMIC_RELAXED, __HIP_MEMORY_SCOPE_AGENT); }
__device__ __forceinline__ unsigned xb_xcc_id() { return (unsigned)__builtin_amdgcn_s_getreg((3 << 11) | 20) & 0xFu; }
#define XB_SPIN(cond, bar) do { unsigned _sp = 0; while (cond) { __builtin_amdgcn_s_sleep(1); \
    if ((++_sp & 255u) == 0u) { if (xb_ld(&(bar)[XB_TMO])) break; if (_sp > XB_SPIN_CAP) { atomicAdd(&(bar)[XB_TMO], 1u); break; } } } } while (0)

struct XcdBarrier {
    unsigned* bar; unsigned x;
    volatile LAS unsigned* st;
};

__device__ __forceinline__ XcdBarrier xcd_barrier_post(unsigned* bar, volatile LAS unsigned* st) {
    XcdBarrier b; b.bar = bar; b.x = xb_xcc_id(); b.st = st;
    if (threadIdx.x == 0) (void)xb_add(&bar[XB_XCNT(b.x)], 1u);
    return b;
}
__device__ __forceinline__ void xcd_barrier_complete(unsigned* bar, unsigned x, unsigned& nloc, unsigned& nx) {
    const unsigned G = gridDim.x * gridDim.y * gridDim.z;
    unsigned sum, cnt, mine, sp = 0u;
    for (;;) {
        sum = 0u; cnt = 0u; mine = 0u;
#pragma unroll
        for (unsigned j = 0; j < 16; ++j) { const unsigned c = xb_ld(&bar[XB_XCNT(j)]); sum += c; cnt += (c > 0u) ? 1u : 0u; mine = (j == x) ? c : mine; }
        if (sum == G) break;
        __builtin_amdgcn_s_sleep(1);
        if ((++sp & 255u) == 0u) { if (xb_ld(&bar[XB_TMO])) break; if (sp > XB_SPIN_CAP) { atomicAdd(&bar[XB_TMO], 1u); break; } }
    }
    nloc = mine > 0u ? mine : 1u; nx = cnt > 0u ? cnt : 1u;
}

__device__ __forceinline__ void xcd_barrier(const XcdBarrier& b) {
    asm volatile("s_waitcnt vmcnt(0)" ::: "memory");
    __syncthreads();
    if (threadIdx.x == 0) {
        unsigned* bar = b.bar;
        __builtin_amdgcn_s_waitcnt(0);
        unsigned nloc = b.st[0], nx = b.st[1];
        if (nloc == 0u) { xcd_barrier_complete(bar, b.x, nloc, nx); b.st[0] = nloc; b.st[1] = nx; }
        const unsigned old = xb_add(&bar[XB_XSUB(b.x)], 1u);
        const unsigned gen = old / nloc;
        if (old + 1u == (gen + 1u) * nloc) {
            __builtin_amdgcn_fence(__ATOMIC_RELEASE, "agent");
            asm volatile("s_waitcnt vmcnt(0)" ::: "memory");
            const unsigned og = xb_add(&bar[XB_TOP], 1u);
            const unsigned tg = og / nx;
            if (og + 1u == (tg + 1u) * nx) xb_add(&bar[XB_TOPGEN], 1u);
            else XB_SPIN(xb_ld(&bar[XB_TOPGEN]) == tg, bar);
            __builtin_amdgcn_fence(__ATOMIC_ACQUIRE, "agent");
            xb_add(&bar[XB_XGEN(b.x)], 1u);
            asm volatile("s_waitcnt vmcnt(0)" ::: "memory");
        } else {
            XB_SPIN(xb_ld(&bar[XB_XGEN(b.x)]) == gen, bar);
            __builtin_amdgcn_fence(__ATOMIC_ACQUIRE, "agent");
            asm volatile("s_waitcnt vmcnt(0)" ::: "memory");
        }
    }
    __syncthreads();
}


DI int colmap(int mode, int n) {
  if (mode == 0) return n;
  const int pn = n >> 8, bj = (n >> 7) & 1, i = n & 127;
  if (mode == 1) return bj * DFF + 128 * pn + i;
  if (n < 2048) return (bj ? 2048 : 1024) + 128 * pn + i;
  if (n < 3072) return n - 2048;
  if (n < 8192) return n;
  if (n < 10240) return n + 32;
  if (n < 10272) return n - 2048;
  return -1;
}

DI void convert_weight(const float* __restrict__ src, const float* __restrict__ kscale, bf16_t* __restrict__ dst, int K, int Nsrc,
                       int Ndst, int mode, char* smem, int rank, int nranks, int tbeg = 0, int tend = 1 << 30) {
  const int tidq = opaque_tid();
  float* tile = (float*)smem;
  const int tid = tidq;
  const int kt_n = K >> 8;
  const int ntiles = (Ndst >> 6) * kt_n;
  for (int t = tbeg + rank; t < ntiles && t < tend; t += nranks) {
    const int n0 = (t / kt_n) << 6, k0 = (t % kt_n) << 8;
    {
      const int i = tid & 63, j0 = tid >> 6;
      const int sc = colmap(mode, n0 + i);
      float v[32];
#pragma unroll
      for (int jj = 0; jj < 32; ++jj) v[jj] = sc >= 0 ? __builtin_nontemporal_load(src + (size_t)(k0 + j0 * 32 + jj) * Nsrc + sc) : 0.f;
#pragma unroll
      for (int jj = 0; jj < 32; ++jj) tile[(j0 * 32 + jj) * 65 + i] = v[jj];
    }
    __syncthreads();
    {
      const int kk = (tid & 127) * 2, r0 = tid >> 7;
      float ks0 = 1.f, ks1 = 1.f;
      if (kscale) { ks0 = kscale[k0 + kk]; ks1 = kscale[k0 + kk + 1]; }
#pragma unroll
      for (int rr = 0; rr < 16; ++rr) {
        const int r = r0 * 16 + rr;
        *(unsigned*)(dst + (size_t)(n0 + r) * K + k0 + kk) = pack2(tile[kk * 65 + r] * ks0, tile[(kk + 1) * 65 + r] * ks1);
      }
    }
    __syncthreads();
  }
}

namespace pg8 {
#define PG8_LAS __attribute__((address_space(3)))
typedef unsigned short bf16_t;
typedef short bf16x8 __attribute__((ext_vector_type(8)));
typedef float f32x4 __attribute__((ext_vector_type(4)));
typedef unsigned u32x4 __attribute__((ext_vector_type(4)));
constexpr int BM = 256, BK = 64, HALF = 128, HTB = HALF * BK * 2  , STAGE_BYTES = 8 * HTB, NXCD = 8, WGM = 2;

__host__ __device__ __forceinline__ int lds_byte(int r, int c) { const int st = (r >> 4) * 2 + (c >> 5), rr = r & 15, cc = c & 31, ob = rr * 64 + cc * 2; return st * 1024 + (ob ^ (((ob >> 9) & 1) << 5)); }
__host__ __device__ __forceinline__ void stage_rc(int b, int& R, int& C) { const int st = b / 1024, sb = b % 1024, swz = sb ^ (((sb >> 9) & 1) << 5); R = (st >> 1) * 16 + swz / 64; C = (st & 1) * 32 + (swz % 64) / 2; }
__host__ __device__ __forceinline__ int perm32(int rho) { const int n = rho >> 4, i = rho & 15; return 8 * (i >> 2) + 4 * n + (i & 3); }
struct Unit { int pm, pn, pk; };
struct Gemm { const bf16_t* A; const bf16_t* Bt; int M, N, K, Kloop; };
struct StaticOrder {
    int nM, nN, nwg, G, c;
    __host__ __device__ void init(int M, int N, int G_, int c_) { nM = M / BM; nN = N / BM; nwg = nM * nN; G = G_; c = c_; }
    __host__ __device__ bool next(int i, Unit& u) const {
        const long L = (long)i * G + c; if (L >= nwg) return false;
        int wgid = (int)L; { const int q = nwg / NXCD, r = nwg % NXCD, xcd = wgid % NXCD, off = wgid / NXCD; wgid = (xcd < r ? xcd * (q + 1) : r * (q + 1) + (xcd - r) * q) + off; }
        const int nig = WGM * nN, gid = wgid / nig, fm = gid * WGM, gsz = (nM - fm) < WGM ? (nM - fm) : WGM;
        u.pm = fm + ((wgid % nig) % gsz); u.pn = (wgid % nig) / gsz; u.pk = 0; return true;
    }
    __device__ __forceinline__ void a_ready(const Unit&) const {}
    __device__ __forceinline__ void done(const Unit&) const {}
};


template <int NP> DI float row_rs(const float* __restrict__ ssp, int row) {
  if (NP == 0) return ssp[row];
  float s = 0.f;
  if (NP == 1) s = ssp[row];
  else {
#pragma unroll
    for (int i = 0; i < NP / 4; ++i) { const f32x4 v = *(const f32x4*)(ssp + (size_t)row * NP + 4 * i); s += v[0] + v[1] + v[2] + v[3]; }
  }
  return rsqrtf(s * (1.f / DM) + EPS);
}

template <int NP> struct EpiSwiglu {
  static constexpr bool PERM = true, AFTER_DRAIN = false;
  bf16_t* ACT; const float* ssp;
  struct Pre { int buf; };
  DI Pre prefetch(const Unit& u, int ui, PG8_LAS unsigned char* lds, int wid, int lane) const {
    if (wid == 0) {
#pragma unroll
      for (int i = 0; i < 4; ++i) {
        int row = u.pm * BM + i * 64 + lane; row = row < MTOT ? row : MTOT - 1;
        __builtin_amdgcn_global_load_lds((const unsigned*)(ssp + row), (PG8_LAS unsigned*)(lds + RS_LDS_OFF + (ui & 1) * 1024 + i * 256), 4, 0, 0);
      }
    }
    return Pre{ui & 1};
  }
  DI void operator()(const f32x4 (&acc)[2][2][4][2], const Unit& u, int wr, int wc, int fr, int fq, const Pre& pre, PG8_LAS unsigned char* lds) const {
    const PG8_LAS float* rsl = (const PG8_LAS float*)(lds + RS_LDS_OFF + pre.buf * 1024);
    const int col = u.pn * 128 + wc * 32 + fq * 8;
#pragma unroll
    for (int ai = 0; ai < 2; ++ai)
#pragma unroll
      for (int m = 0; m < 4; ++m) {
        const int row = u.pm * BM + ai * HALF + wr * 64 + m * 16 + fr;
        if (row < MTOT) {
          const float rsin = rsl[ai * HALF + wr * 64 + m * 16 + fr];
          const float rs = NP == 0 ? rsin : rsqrtf(rsin * (1.f / DM) + EPS);
          const f32x4 g0 = acc[ai][0][m][0] * rs, g1 = acc[ai][0][m][1] * rs, u0 = acc[ai][1][m][0] * rs, u1 = acc[ai][1][m][1] * rs;
          uint4 o;
          o.x = pack2(siluf_(g0[0]) * u0[0], siluf_(g0[1]) * u0[1]);
          o.y = pack2(siluf_(g0[2]) * u0[2], siluf_(g0[3]) * u0[3]);
          o.z = pack2(siluf_(g1[0]) * u1[0], siluf_(g1[1]) * u1[1]);
          o.w = pack2(siluf_(g1[2]) * u1[2], siluf_(g1[3]) * u1[3]);
          *(uint4*)(ACT + (size_t)row * DFF + col) = o;
        }
      }
  }
};

struct EpiDown {
  static constexpr bool PERM = false, AFTER_DRAIN = false;
  const float *x_prompt, *x_sample, *meta; float* H; int resid_from_x; float scale; bf16_t* HB; float* sspo;
  struct Pre {};
  DI Pre prefetch(const Unit&, int, PG8_LAS unsigned char*, int, int) const { return Pre{}; }
  DI void operator()(const f32x4 (&acc)[2][2][4][2], const Unit& u, int wr, int wc, int fr, int fq, const Pre&, PG8_LAS unsigned char*) const {
#pragma unroll
    for (int ai = 0; ai < 2; ++ai)
#pragma unroll
      for (int m = 0; m < 4; ++m) {
        const int row = u.pm * BM + ai * HALF + wr * 64 + m * 16 + fr;
        const bool ok = row < MTOT;
        float part = 0.f;
        if (ok) {
          float* hrow = H + (size_t)row * DM;
          const float* res = resid_from_x ? xrow_ptr(x_prompt, x_sample, meta, row) : hrow;
#pragma unroll
          for (int bj = 0; bj < 2; ++bj)
#pragma unroll
            for (int n = 0; n < 2; ++n) {
              const int col = u.pn * BM + bj * HALF + wc * 32 + n * 16 + fq * 4;
              const f32x4 r = *(const f32x4*)(res + col);
              const f32x4 h = r + acc[ai][bj][m][n] * scale;
              *(f32x4*)(hrow + col) = h;
              if (HB) { uint2 o; o.x = pack2(h[0], h[1]); o.y = pack2(h[2], h[3]); *(uint2*)(HB + (size_t)row * DM + col) = o; }
              part += h[0] * h[0] + h[1] * h[1] + h[2] * h[2] + h[3] * h[3];
            }
        }
        part += __shfl_xor(part, 16);
        part += __shfl_xor(part, 32);
        if (ok && fq == 0) sspo[(size_t)row * 16 + u.pn * 4 + wc] = part;
      }
  }
};

struct EpiInproj {
  static constexpr bool PERM = true, AFTER_DRAIN = false;
  const float* ssp; float* out; char* ws; const float* dt_bias;
#define EPI_WS(name) ((bf16_t*)(ws + O_##name))
  DI static void st8(bf16_t* dst, const f32x4& a, const f32x4& b) {
    uint4 o; o.x = pack2(a[0], a[1]); o.y = pack2(a[2], a[3]); o.z = pack2(b[0], b[1]); o.w = pack2(b[2], b[3]);
    *(uint4*)dst = o;
  }
  struct Pre { int buf; };
  DI Pre prefetch(const Unit& u, int ui, PG8_LAS unsigned char* lds, int wid, int lane) const {
    if (wid == 0) {
#pragma unroll
      for (int i = 0; i < 4; ++i) {
        int row = u.pm * BM + i * 64 + lane; row = row < MTOT ? row : MTOT - 1;
        __builtin_amdgcn_global_load_lds((const unsigned*)(ssp + row), (PG8_LAS unsigned*)(lds + RS_LDS_OFF + (ui & 1) * 1024 + i * 256), 4, 0, 0);
      }
    }
    return Pre{ui & 1};
  }
  DI void operator()(const f32x4 (&acc)[2][2][4][2], const Unit& u, int wr, int wc, int fr, int fq, const Pre& pre, PG8_LAS unsigned char* lds) const {
    const PG8_LAS float* rsl = (const PG8_LAS float*)(lds + RS_LDS_OFF + pre.buf * 1024);
    const int pn = u.pn;
    const int cw = wc * 32 + fq * 8;
#pragma unroll
    for (int ai = 0; ai < 2; ++ai)
#pragma unroll
      for (int m = 0; m < 4; ++m) {
        const int row = u.pm * BM + ai * HALF + wr * 64 + m * 16 + fr;
        if (row >= MTOT) continue;
        const float rs = rsl[ai * HALF + wr * 64 + m * 16 + fr];
        int b, tt;
        const bool samp = row >= MP;
        if (!samp) { b = row / LP; tt = row - b * LP; } else { b = (row - MP) >> 2; tt = (row - MP) & 3; }
        if (pn < 8) {
          const f32x4 v0 = (acc[ai][0][m][0] * rs) * (acc[ai][1][m][0] * rs), v1 = (acc[ai][0][m][1] * rs) * (acc[ai][1][m][1] * rs);
          const int col = pn * 128 + cw;
          st8(EPI_WS(CH) + (size_t)row * DM + col, v0, v1);
          const int idx = samp ? tt - 2 : tt - (LP - 2);
          if (idx >= 0) {
            float* so = out + (samp ? OFF_SCA : OFF_PCA) + ((size_t)b * 2 + idx) * 1024 + col;
            *(f32x4*)so = v0; *(f32x4*)(so + 4) = v1;
          }
        } else if (pn < 12) {
#pragma unroll
          for (int bj = 0; bj < 2; ++bj)
            st8(EPI_WS(AB) + (size_t)row * DM + (pn - 8) * 256 + bj * 128 + cw, acc[ai][bj][m][0] * rs, acc[ai][bj][m][1] * rs);
        } else if (pn < 20) {
#pragma unroll
          for (int bj = 0; bj < 2; ++bj)
            st8(EPI_WS(R0) + (size_t)row * DSSM + (pn - 12) * 256 + bj * 128 + cw, acc[ai][bj][m][0] * rs, acc[ai][bj][m][1] * rs);
        } else if (pn < 32) {
          const int idx = samp ? tt - 1 : tt - (LP - 3);
#pragma unroll
          for (int bj = 0; bj < 2; ++bj) {
            const int col = (pn - 20) * 256 + bj * 128 + cw;
            const f32x4 v0 = acc[ai][bj][m][0] * rs, v1 = acc[ai][bj][m][1] * rs;
            st8(EPI_WS(XBC) + (size_t)row * DXBC + col, v0, v1);
            if (!samp && (tt & 63) >= 13 && (tt & 63) <= 15)
              st8(EPI_WS(HALO) + ((size_t)(b * 34 + (tt >> 6) + 1) * 3 + ((tt & 63) - 13)) * DXBC + col, v0, v1);
            if (idx >= 0) {
              float* so = out + (samp ? OFF_SSC : OFF_PSC) + ((size_t)b * 3 + idx) * DXBC + col;
              *(f32x4*)so = v0; *(f32x4*)(so + 4) = v1;
            }
          }
        } else if (pn < 40) {
          bf16_t* SG = pn < 36 ? EPI_WS(SGA) : EPI_WS(SGB);
          const int pb = pn < 36 ? 32 : 36;
#pragma unroll
          for (int bj = 0; bj < 2; ++bj) {
            f32x4 v0 = acc[ai][bj][m][0] * rs, v1 = acc[ai][bj][m][1] * rs;
#pragma unroll
            for (int j = 0; j < 4; ++j) { v0[j] = sigmoidf_(v0[j]); v1[j] = sigmoidf_(v1[j]); }
            st8(SG + (size_t)row * DM + (pn - pb) * 256 + bj * 128 + cw, v0, v1);
          }
        } else {
          if (wc == 0) {
            f32x4 v0 = acc[ai][0][m][0] * rs, v1 = acc[ai][0][m][1] * rs;
            const f32x4 b0 = *(const f32x4*)(dt_bias + fq * 8), b1 = *(const f32x4*)(dt_bias + fq * 8 + 4);
#pragma unroll
            for (int j = 0; j < 4; ++j) {
              float a = v0[j] + b0[j]; v0[j] = a > 20.f ? a : log1pf(__expf(a));
              float c = v1[j] + b1[j]; v1[j] = c > 20.f ? c : log1pf(__expf(c));
            }
            *(f32x4*)((float*)(ws + O_DT) + (size_t)row * 32 + fq * 8) = v0;
            *(f32x4*)((float*)(ws + O_DT) + (size_t)row * 32 + fq * 8 + 4) = v1;
          }
        }
      }
  }
};

template <bool ADD> struct EpiGate {
  static constexpr bool PERM = true, AFTER_DRAIN = false;
  bf16_t* O; const bf16_t* G;
  struct Pre {};
  DI Pre prefetch(const Unit&, int, PG8_LAS unsigned char*, int, int) const { return Pre{}; }
  DI void operator()(const f32x4 (&acc)[2][2][4][2], const Unit& u, int wr, int wc, int fr, int fq, const Pre&, PG8_LAS unsigned char*) const {
#pragma unroll
    for (int ai = 0; ai < 2; ++ai)
#pragma unroll
      for (int m = 0; m < 4; ++m) {
        const int row = u.pm * BM + ai * HALF + wr * 64 + m * 16 + fr;
        if (row >= MTOT) continue;
#pragma unroll
        for (int bj = 0; bj < 2; ++bj) {
          const size_t off = (size_t)row * DM + u.pn * BM + bj * HALF + wc * 32 + fq * 8;
          const uint4 g = *(const uint4*)(G + off);
          const f32x4 a0 = acc[ai][bj][m][0], a1 = acc[ai][bj][m][1];
          float v[8] = {a0[0] * bflo(g.x), a0[1] * bfhi(g.x), a0[2] * bflo(g.y), a0[3] * bfhi(g.y),
                        a1[0] * bflo(g.z), a1[1] * bfhi(g.z), a1[2] * bflo(g.w), a1[3] * bfhi(g.w)};
          if (ADD) {
            const uint4 o = *(const uint4*)(O + off);
            v[0] += bflo(o.x); v[1] += bfhi(o.x); v[2] += bflo(o.y); v[3] += bfhi(o.y);
            v[4] += bflo(o.z); v[5] += bfhi(o.z); v[6] += bflo(o.w); v[7] += bfhi(o.w);
          }
          uint4 r; r.x = pack2(v[0], v[1]); r.y = pack2(v[2], v[3]); r.z = pack2(v[4], v[5]); r.w = pack2(v[6], v[7]);
          *(uint4*)(O + off) = r;
        }
      }
  }
};

template <class Epi, class Sched, bool STAMP = false>
__device__ __forceinline__ void gemm_phase(PG8_LAS unsigned char* lds, const Gemm g, const Sched& S, const Epi& E, unsigned long long* stamps) {
    const int tid = opaque_tid(), wid = __builtin_amdgcn_readfirstlane(tid >> 6), lane = tid & 63, wr = wid >> 2, wc = wid & 3, fr = lane & 15, fq = lane >> 4;
    const int K = g.K, nt = g.Kloop / BK;
    int ts_lo = 0, ts_hi = 0, nts = 0; const unsigned long long rt_entry = STAMP ? (unsigned long long)wall_clock64() : 0ull;
#define PG8_STAMP() do { if (STAMP && wid == 0 && nts < 64) { const unsigned long long _c = (unsigned long long)clock64(); \
        ts_lo = (lane == nts) ? (int)(unsigned)_c : ts_lo; ts_hi = (lane == nts) ? (int)(unsigned)(_c >> 32) : ts_hi; ++nts; } } while (0)
    PG8_STAMP();
    unsigned voffA[2], voffB[2];
#pragma unroll
    for (int i = 0; i < 2; ++i) { int R, C; stage_rc(tid * 16 + i * 8192, R, C); const int Rb = Epi::PERM ? ((R & ~31) + perm32(R & 31)) : R;
        voffA[i] = (unsigned)(R * K + C) * 2u; voffB[i] = (unsigned)(Rb * K + C) * 2u; }
    const size_t kstep = (size_t)(BK * 2);
    const size_t hstep = (size_t)HALF * K * 2;
    const size_t tstep = 2 * hstep;
    const unsigned ldsw = (unsigned)wid * 1024u;
    const int aoff = lds_byte(wr * 64 + fr, fq * 8), boff = lds_byte(wc * 32 + fr, fq * 8);
#define PG8_SA(b, h) (((b) * 2 + (h)) * HTB)
#define PG8_SB(b, h) ((4 + (b) * 2 + (h)) * HTB)
#define PG8_STAGE(bufoff, gbase, voff) do { _Pragma("unroll") for (int _i = 0; _i < 2; ++_i) \
        __builtin_amdgcn_global_load_lds((const unsigned*)((const char*)(gbase) + (voff)[_i]), (PG8_LAS unsigned*)(lds + (bufoff) + ldsw + _i * 8192), 16, 0, 0); } while (0)
#define PG8_LDA(dst, b, h) do { _Pragma("unroll") for (int m = 0; m < 4; ++m) _Pragma("unroll") for (int k = 0; k < 2; ++k) dst[m][k] = *(const PG8_LAS bf16x8*)(lds + PG8_SA(b, h) + aoff + m * 2048 + k * 1024); } while (0)
#define PG8_LDB(dst, b, h) do { _Pragma("unroll") for (int n = 0; n < 2; ++n) _Pragma("unroll") for (int k = 0; k < 2; ++k) dst[n][k] = *(const PG8_LAS bf16x8*)(lds + PG8_SB(b, h) + boff + n * 2048 + k * 1024); } while (0)
#define PG8_MMA(ai, bj, At, Bt) do { __builtin_amdgcn_s_setprio(1); _Pragma("unroll") for (int m = 0; m < 4; ++m) _Pragma("unroll") for (int n = 0; n < 2; ++n) _Pragma("unroll") for (int k = 0; k < 2; ++k) \
        acc[ai][bj][m][n] = __builtin_amdgcn_mfma_f32_16x16x32_bf16(Bt[n][k], At[m][k], acc[ai][bj][m][n], 0, 0, 0); __builtin_amdgcn_s_setprio(0); } while (0)
#define PG8_WAIT_V(n) asm volatile("s_waitcnt vmcnt(" #n ")" ::: "memory")
#define PG8_WAIT_L(n) asm volatile("s_waitcnt lgkmcnt(" #n ")" ::: "memory")
#define PG8_BAR __builtin_amdgcn_s_barrier()
#define PG8_SCHED __builtin_amdgcn_sched_barrier(0)
    Unit cur, nxt; int ui = 0;
    if (!S.next(0, cur)) return;
    f32x4 acc[2][2][4][2];
#pragma unroll
    for (int a = 0; a < 2; ++a)
#pragma unroll
        for (int b = 0; b < 2; ++b)
#pragma unroll
            for (int m = 0; m < 4; ++m)
#pragma unroll
                for (int n = 0; n < 2; ++n) acc[a][b][m][n] = (f32x4){0.f, 0.f, 0.f, 0.f};
    bf16x8 At[4][2], B0[2][2], B1[2][2];
    const char* cA = (const char*)g.A + (size_t)cur.pm * tstep + (size_t)cur.pk * g.Kloop * 2; const char* cB = (const char*)g.Bt + (size_t)cur.pn * tstep + (size_t)cur.pk * g.Kloop * 2;
    S.a_ready(cur);
    PG8_STAGE(PG8_SB(0, 0), cB, voffB); PG8_STAGE(PG8_SA(0, 0), cA, voffA); PG8_STAGE(PG8_SB(0, 1), cB + hstep, voffB); PG8_STAGE(PG8_SA(0, 1), cA + hstep, voffA);
    if (wr == 1) PG8_BAR;
    PG8_WAIT_V(4); PG8_BAR;
    PG8_STAGE(PG8_SB(1, 0), cB + kstep, voffB); PG8_STAGE(PG8_SA(1, 0), cA + kstep, voffA); PG8_STAGE(PG8_SB(1, 1), cB + hstep + kstep, voffB);
    PG8_WAIT_V(6); PG8_BAR;
    PG8_STAMP();
    for (;;) {
        const bool has_next = S.next(ui + 1, nxt);
        const char* nA = has_next ? (const char*)g.A + (size_t)nxt.pm * tstep + (size_t)nxt.pk * g.Kloop * 2 : cA; const char* nB = has_next ? (const char*)g.Bt + (size_t)nxt.pn * tstep + (size_t)nxt.pk * g.Kloop * 2 : cB;
        const typename Epi::Pre pre = E.prefetch(cur, ui, lds, wid, lane);
        for (int t = 0; t < nt; t += 2) {
            const bool last = (t == nt - 2);
            const char* a1 = cA + (size_t)(t + 1) * kstep;
            const char* a2 = last ? nA : cA + (size_t)(t + 2) * kstep; const char* b2 = last ? nB : cB + (size_t)(t + 2) * kstep;
            const char* a3 = a2 + kstep; const char* b3 = b2 + kstep;
            if (last && has_next) S.a_ready(nxt);
            PG8_LDB(B0, 0, 0); PG8_SCHED; PG8_LDA(At, 0, 0); PG8_STAGE(PG8_SA(1, 1), a1 + hstep, voffA);
            PG8_WAIT_L(8); PG8_BAR; PG8_WAIT_L(0); PG8_MMA(0, 0, At, B0); PG8_BAR; PG8_SCHED;
            PG8_LDB(B1, 0, 1); PG8_STAGE(PG8_SB(0, 0), b2, voffB);
            PG8_BAR; PG8_WAIT_L(0); PG8_MMA(0, 1, At, B1); PG8_BAR;
            PG8_LDA(At, 0, 1); PG8_STAGE(PG8_SA(0, 0), a2, voffA);
            PG8_BAR; PG8_WAIT_L(0); PG8_MMA(1, 0, At, B0); PG8_BAR; PG8_SCHED;
            PG8_STAGE(PG8_SB(0, 1), b2 + hstep, voffB);
            PG8_WAIT_V(6); PG8_BAR; PG8_MMA(1, 1, At, B1); PG8_BAR;
            PG8_LDB(B0, 1, 0); PG8_SCHED; PG8_LDA(At, 1, 0); PG8_STAGE(PG8_SA(0, 1), a2 + hstep, voffA);
            PG8_WAIT_L(8); PG8_BAR; PG8_WAIT_L(0); PG8_MMA(0, 0, At, B0); PG8_BAR; PG8_SCHED;
            PG8_LDB(B1, 1, 1); PG8_STAGE(PG8_SB(1, 0), b3, voffB);
            PG8_BAR; PG8_WAIT_L(0); PG8_MMA(0, 1, At, B1); PG8_BAR;
            PG8_LDA(At, 1, 1); PG8_STAGE(PG8_SA(1, 0), a3, voffA);
            PG8_BAR; PG8_WAIT_L(0); PG8_MMA(1, 0, At, B0); PG8_BAR; PG8_SCHED;
            PG8_STAGE(PG8_SB(1, 1), b3 + hstep, voffB);
            PG8_WAIT_V(6); PG8_BAR; PG8_MMA(1, 1, At, B1); PG8_BAR;
        }
        PG8_STAMP();
        if constexpr (!Epi::AFTER_DRAIN) { E(acc, cur, wr, wc, fr, fq, pre, lds); S.done(cur); }
        PG8_STAMP();
        if (!has_next) break;
#pragma unroll
        for (int a = 0; a < 2; ++a)
#pragma unroll
            for (int b = 0; b < 2; ++b)
#pragma unroll
                for (int m = 0; m < 4; ++m)
#pragma unroll
                    for (int n = 0; n < 2; ++n) acc[a][b][m][n] = (f32x4){0.f, 0.f, 0.f, 0.f};
        cur = nxt; cA = nA; cB = nB; ++ui;
    }
    PG8_WAIT_V(0);
    if (wr == 0) PG8_BAR;
    PG8_BAR;
    if constexpr (Epi::AFTER_DRAIN) { E.fused(acc, cur, wr, wc, fr, fq, lds, wid, lane); S.done(cur); }
    PG8_STAMP();
    if (STAMP && wid == 0) { stamps[lane] = lane < nts ? (((unsigned long long)(unsigned)ts_hi << 32) | (unsigned)ts_lo) : 0ull;
        if (lane == 62) stamps[62] = rt_entry; if (lane == 63) stamps[63] = (unsigned long long)wall_clock64(); }
#undef PG8_STAMP
#undef PG8_SA
#undef PG8_SB
#undef PG8_STAGE
#undef PG8_LDA
#undef PG8_LDB
#undef PG8_MMA
#undef PG8_WAIT_V
#undef PG8_WAIT_L
#undef PG8_BAR
#undef PG8_SCHED
}
}


namespace pg8 {
struct PanelOrder {
  int c;
  __device__ __forceinline__ bool next(int i, Unit& u) const { if (i > 0) return false; const int x = c & 7, r = c >> 3; u.pm = 8 * x + (r & 7); u.pn = r >> 3; u.pk = 0; return true; }
  __device__ __forceinline__ void a_ready(const Unit&) const {}
  __device__ __forceinline__ void done(const Unit&) const {}
};
struct TailOrder {
  int c, S, c0;
  __device__ __forceinline__ bool next(int i, Unit& u) const { const int cc = c - c0; if (i > 0 || cc < 0 || cc >= 12 * S) return false; const int t = cc / S; u.pm = 64 + (t >> 2); u.pn = t & 3; u.pk = cc - t * S; return true; }
  __device__ __forceinline__ void a_ready(const Unit&) const {}
  __device__ __forceinline__ void done(const Unit&) const {}
};
struct EpiSlab {
  static constexpr bool PERM = false, AFTER_DRAIN = false;
  float* slab;
  struct Pre {};
  DI Pre prefetch(const Unit&, int, PG8_LAS unsigned char*, int, int) const { return Pre{}; }
  DI void operator()(const f32x4 (&acc)[2][2][4][2], const Unit& u, int wr, int wc, int fr, int fq, const Pre&, PG8_LAS unsigned char*) const {
#pragma unroll
    for (int ai = 0; ai < 2; ++ai)
#pragma unroll
      for (int m = 0; m < 4; ++m) {
        const int lr = (u.pm - 64) * BM + ai * HALF + wr * 64 + m * 16 + fr;
        float* rowp = slab + ((size_t)u.pk * 768 + lr) * DM;
#pragma unroll
        for (int bj = 0; bj < 2; ++bj)
#pragma unroll
          for (int n = 0; n < 2; ++n) *(f32x4*)(rowp + u.pn * BM + bj * HALF + wc * 32 + n * 16 + fq * 4) = acc[ai][bj][m][n];
      }
  }
};
}
DI int unit_c(const char* smem) { return __builtin_amdgcn_readfirstlane(*(const int*)(smem + SITEM_OFF + 36)); }
template <class Epi> DI void run_gemm_panel(char* smem, const bf16_t* A, const bf16_t* Bt, int N, int K, const Epi& E) {
  pg8::PanelOrder S{unit_c(smem)};
  pg8::Gemm g{A, Bt, MPAD, N, K, K};
  pg8::gemm_phase<Epi, pg8::PanelOrder, false>((PG8_LAS unsigned char*)smem, g, S, E, nullptr);
}
DI void run_gemm_tail(char* smem, const bf16_t* A, const bf16_t* Bt, int N, int K, int nsplit, float* slab, int c0 = 0) {
  pg8::TailOrder S{unit_c(smem), nsplit, c0};
  pg8::Gemm g{A, Bt, MPAD, N, K, K / nsplit};
  pg8::EpiSlab E{slab};
  pg8::gemm_phase<pg8::EpiSlab, pg8::TailOrder, false>((PG8_LAS unsigned char*)smem, g, S, E, nullptr);
}
constexpr int TAIL_ROW0 = 16384;
template <int NS> DI void fixup_down(const Params& p, bool resid_from_x, float scale, bf16_t* HB) {
  const int tidq = opaque_tid();
  const int lane = tidq & 63, wid = tidq >> 6;
  const float* slab = (const float*)WSB(p, XBC);
  for (int row = TAIL_ROW0 + blockIdx.x * 8 + wid; row < MTOT; row += gridDim.x * 8) {
    float* hrow = WSF(p, H) + (size_t)row * DM;
    const float* res = resid_from_x ? xrow_ptr(p.x_prompt, p.x_sample, p.meta, row) : hrow;
    float ss = 0.f;
#pragma unroll
    for (int i = 0; i < 4; ++i) {
      const int col = i * 256 + lane * 4;
      f32x4 a = {0.f, 0.f, 0.f, 0.f};
      f32x4 pv[NS];
#pragma unroll
      for (int k = 0; k < NS; ++k) pv[k] = *(const f32x4*)(slab + ((size_t)k * 768 + (row - TAIL_ROW0)) * DM + col);
#pragma unroll
      for (int k = 0; k < NS; ++k) a += pv[k];
      const f32x4 h = *(const f32x4*)(res + col) + a * scale;
      *(f32x4*)(hrow + col) = h;
      if (HB) { uint2 o; o.x = pack2(h[0], h[1]); o.y = pack2(h[2], h[3]); *(uint2*)(HB + (size_t)row * DM + col) = o; }
      ss += h[0] * h[0] + h[1] * h[1] + h[2] * h[2] + h[3] * h[3];
    }
#pragma unroll
    for (int d = 1; d < 64; d <<= 1) ss += __shfl_xor(ss, d);
    if (lane < 16) WSF(p, ssp)[(size_t)row * 16 + lane] = lane == 0 ? ss : 0.f;
    if (lane == 0) WSF(p, rsv)[row] = rsqrtf(ss * (1.f / DM) + EPS);
  }
  for (int row = blockIdx.x * NTHREADS + tidq; row < TAIL_ROW0; row += gridDim.x * NTHREADS) {
    const float* sp = WSF(p, ssp) + (size_t)row * 16;
    const f32x4 a = *(const f32x4*)sp, b = *(const f32x4*)(sp + 4), c = *(const f32x4*)(sp + 8), d = *(const f32x4*)(sp + 12);
    const float ss = (a[0] + a[1] + a[2] + a[3]) + (b[0] + b[1] + b[2] + b[3]) + (c[0] + c[1] + c[2] + c[3]) + (d[0] + d[1] + d[2] + d[3]);
    WSF(p, rsv)[row] = rsqrtf(ss * (1.f / DM) + EPS);
  }
}

DI void fixup_merge(const Params& p) {
  const int tidq = opaque_tid();
  const float* slab = (const float*)WSB(p, XBC);
  const int gt = blockIdx.x * NTHREADS + tidq, gn = gridDim.x * NTHREADS;
  for (int idx = gt; idx < (MTOT - TAIL_ROW0) * 256; idx += gn) {
    const int lr = idx >> 8, col = (idx & 255) * 4;
    f32x4 a = {0.f, 0.f, 0.f, 0.f}, b = {0.f, 0.f, 0.f, 0.f};
#pragma unroll
    for (int k = 0; k < 4; ++k) a += *(const f32x4*)(slab + ((size_t)k * 768 + lr) * DM + col);
#pragma unroll
    for (int k = 0; k < 8; ++k) b += *(const f32x4*)(slab + ((size_t)(4 + k) * 768 + lr) * DM + col);
    const size_t off = (size_t)(TAIL_ROW0 + lr) * DM + col;
    const uint2 ga = *(const uint2*)(WSB(p, SGA) + off), gb = *(const uint2*)(WSB(p, SGB) + off);
    uint2 o;
    o.x = pack2(a[0] * bflo(ga.x) + b[0] * bflo(gb.x), a[1] * bfhi(ga.x) + b[1] * bfhi(gb.x));
    o.y = pack2(a[2] * bflo(ga.y) + b[2] * bflo(gb.y), a[3] * bfhi(ga.y) + b[3] * bfhi(gb.y));
    *(uint2*)(WSB(p, AB) + off) = o;
  }
}

template <class Epi> DI void run_gemm(char* smem, const bf16_t* A, const bf16_t* Bt, int N, int K, const Epi& E) {
  pg8::StaticOrder S;
  S.init(MPAD, N, (int)gridDim.x, __builtin_amdgcn_readfirstlane(*(const int*)(smem + SITEM_OFF + 36)));
  pg8::Gemm g{A, Bt, MPAD, N, K, K};
  pg8::gemm_phase<Epi, pg8::StaticOrder, false>((PG8_LAS unsigned char*)smem, g, S, E, nullptr);
}

constexpr int SC_OFF = 0, SB_OFF = 17408, SXT_OFF = 34816, SH_OFF = 44032, SG_OFF = 61440, SDT_OFF = 70656, SACS_OFF = 70912,
              SWT_OFF = 71168;
constexpr int LDN = 136;
constexpr int LDQ = 72;

DI void unpack8(const uint4& u, float (&v)[8]) {
  v[0] = bflo(u.x); v[1] = bfhi(u.x); v[2] = bflo(u.y); v[3] = bfhi(u.y);
  v[4] = bflo(u.z); v[5] = bfhi(u.z); v[6] = bflo(u.w); v[7] = bfhi(u.w);
}

DI void phase_conv(const Params& p) {
  const int tidq = opaque_tid();
  const int gt = blockIdx.x * NTHREADS + tidq, gn = gridDim.x * NTHREADS;
  constexpr int NPI = 8 * 33 * 384, NSI = 128 * 384;
  bf16_t* XBC = WSB(p, XBC);
  const bf16_t* HALO = WSB(p, HALO);
  for (int idx = gt; idx < NPI + NSI; idx += gn) {
    int ch, t0, t1, rowbase;
    float x0[8], x1[8], x2[8];
    if (idx < NPI) {
      const int ch8 = idx % 384, r = idx / 384, c = r % 33, b = r / 33;
      ch = ch8 * 8;
      t0 = c == 0 ? 0 : 64 * c - 48; t1 = 64 * c + 16; rowbase = b * LP;
      if (c == 0) {
#pragma unroll
        for (int e = 0; e < 8; ++e) { x0[e] = 0.f; x1[e] = 0.f; x2[e] = 0.f; }
      } else {
        const bf16_t* hp = HALO + (size_t)(b * 34 + c) * 3 * DXBC + ch;
        unpack8(*(const uint4*)hp, x0); unpack8(*(const uint4*)(hp + DXBC), x1); unpack8(*(const uint4*)(hp + 2 * DXBC), x2);
      }
    } else {
      const int i2 = idx - NPI, ch8 = i2 % 384, b = i2 / 384;
      ch = ch8 * 8;
      t0 = 0; t1 = 4; rowbase = MP + b * 4;
      const float* hp = p.st_ssm_conv + (size_t)b * 3 * DXBC + ch;
#pragma unroll
      for (int e = 0; e < 8; ++e) { x0[e] = hp[e]; x1[e] = hp[DXBC + e]; x2[e] = hp[2 * DXBC + e]; }
    }
    float w0[8], w1[8], w2[8], w3[8], bs[8];
#pragma unroll
    for (int e = 0; e < 8; ++e) {
      w0[e] = p.ssm_conv_w[ch + e]; w1[e] = p.ssm_conv_w[DXBC + ch + e]; w2[e] = p.ssm_conv_w[2 * DXBC + ch + e]; w3[e] = p.ssm_conv_w[3 * DXBC + ch + e];
      bs[e] = p.ssm_conv_b[ch + e];
    }
    const int GR = (t1 - t0) >= 8 ? 8 : 4;
    for (int t = t0; t < t1; t += GR) {
      bf16_t* rp = XBC + (size_t)(rowbase + t) * DXBC + ch;
      uint4 raw[8];
#pragma unroll
      for (int k = 0; k < 8; ++k) if (k < GR) raw[k] = *(const uint4*)(rp + (size_t)k * DXBC);
#pragma unroll
      for (int k = 0; k < 8; ++k) if (k < GR) {
        float x3[8], o[8];
        unpack8(raw[k], x3);
#pragma unroll
        for (int e = 0; e < 8; ++e) {
          o[e] = siluf_(bs[e] + w0[e] * x0[e] + w1[e] * x1[e] + w2[e] * x2[e] + w3[e] * x3[e]);
          x0[e] = x1[e]; x1[e] = x2[e]; x2[e] = x3[e];
        }
        uint4 pk;
        pk.x = pack2(o[0], o[1]); pk.y = pack2(o[2], o[3]); pk.z = pack2(o[4], o[5]); pk.w = pack2(o[6], o[7]);
        *(uint4*)(rp + (size_t)k * DXBC) = pk;
      }
    }
  }
}

DI void ua_slice(const Params& p, int slice, int nslices, int tid) {
  bf16_t* UA = WSB(p, R1);
  const bf16_t* CH = WSB(p, CH);
  const bf16_t* AB = WSB(p, AB);
  const int c0 = (tid & 127) * 8;
#pragma unroll 1
  for (int rp = slice; rp < MTOT / 2; rp += nslices) {
    const int row = 2 * rp + (tid >> 7);
    int b, t;
    const bool smp = row >= MP;
    if (!smp) { b = row / LP; t = row - b * LP; } else { b = (row - MP) >> 2; t = (row - MP) & 3; }
    const uint4 ab = *(const uint4*)(AB + (size_t)row * DM + c0);
    uint4 ch[3];
#pragma unroll
    for (int k = 0; k < 3; ++k) ch[k] = *(const uint4*)(CH + (size_t)(row - ((t - 2 + k) >= 0 ? 2 - k : 0)) * DM + c0);
    float conv[8];
#pragma unroll
    for (int e = 0; e < 8; ++e) conv[e] = 0.f;
#pragma unroll
    for (int k = 0; k < 3; ++k) {
      const int tt = t - 2 + k;
      float v[8];
      if (tt >= 0) {
        unpack8(ch[k], v);
      } else if (smp) {
        const float* hp = p.st_conv_a + ((size_t)b * 2 + (tt + 2)) * DM + c0;
        const float4 a0 = *(const float4*)hp, a1 = *(const float4*)(hp + 4);
        v[0] = a0.x; v[1] = a0.y; v[2] = a0.z; v[3] = a0.w; v[4] = a1.x; v[5] = a1.y; v[6] = a1.z; v[7] = a1.w;
      } else {
#pragma unroll
        for (int e = 0; e < 8; ++e) v[e] = 0.f;
      }
      const float4 w0 = *(const float4*)(p.conv_a_w + k * DM + c0), w1 = *(const float4*)(p.conv_a_w + k * DM + c0 + 4);
      conv[0] += w0.x * v[0]; conv[1] += w0.y * v[1]; conv[2] += w0.z * v[2]; conv[3] += w0.w * v[3];
      conv[4] += w1.x * v[4]; conv[5] += w1.y * v[5]; conv[6] += w1.z * v[6]; conv[7] += w1.w * v[7];
    }
    float av[8];
    unpack8(ab, av);
    uint4 o;
    o.x = pack2(av[0] * conv[0], av[1] * conv[1]);
    o.y = pack2(av[2] * conv[2], av[3] * conv[3]);
    o.z = pack2(av[4] * conv[4], av[5] * conv[5]);
    o.w = pack2(av[6] * conv[6], av[7] * conv[7]);
    *(uint4*)(UA + (size_t)row * DM + c0) = o;
  }
}

constexpr int SAL_OFF = 71424;
DI void phase_ssd(const Params& p, char* smem_all, int dry) {
  const int half = threadIdx.x >> 8;
  char* smem = smem_all + half * SSD_HALF_BYTES;
  const int tid = opaque_tid() & 255;
  int tidx = tid, lane = tid & 63, w = tid >> 6, fr = lane & 15, fq = lane >> 4;
  bf16_t* sC = (bf16_t*)(smem + SC_OFF);
  bf16_t* sB = (bf16_t*)(smem + SB_OFF);
  bf16_t* sXT = (bf16_t*)(smem + SXT_OFF);
  bf16_t* sH = (bf16_t*)(smem + SH_OFF);
  bf16_t* sG = (bf16_t*)(smem + SG_OFF);
  float* s_dt = (float*)(smem + SDT_OFF);
  float* s_acs = (float*)(smem + SACS_OFF);
  float* s_wt = (float*)(smem + SWT_OFF);
  float* s_al = (float*)(smem + SAL_OFF);
  const bf16_t* XC = WSB(p, XBC);
  bf16_t* ZY = WSB(p, R0);
  const float* DT = WSF(p, DT);
  const bool samp = half == 1;
  const int nreal = samp ? 16 : 33;
  const int uc = unit_c(smem_all);
  const int item0 = samp ? uc * 16 : (uc & 7) * 32 + (uc >> 3);
  int cc = tid & 7, ix = tid >> 3;
  int c16 = tid & 15, ib = tid >> 4;

  if (tid < 32) { s_al[tid] = -__expf(p.a_log[tid]); s_al[32 + tid] = p.d_skip[tid]; }
  if (!samp) __builtin_amdgcn_s_setprio(2);

  uint4 rx[2], rb[4], rc[4];
  uint2 rz[4];
  float dtv = 0.f;
  f32x4 hacc[4][2], hnext[4][2];
  const uint4 zero4 = make_uint4(0u, 0u, 0u, 0u);
#define SSD_STEP(k_, h_, rowbase_, tb_, L_) do { \
    if (samp) { const int it_ = item0 + (k_); h_ = it_ & 31; rowbase_ = MP + (it_ >> 5) * 4; tb_ = 0; L_ = 4; } \
    else { h_ = item0 & 31; rowbase_ = (item0 >> 5) * LP; tb_ = (k_) * 64 - 48; L_ = LP; } } while (0)
#define SSD_PREFETCH(k_) do { \
    int h_, rowbase_, tb_, L_; SSD_STEP(k_, h_, rowbase_, tb_, L_); const int g_ = h_ >> 3; \
    _Pragma("unroll") for (int u = 0; u < 2; ++u) { \
      const int t_ = tb_ + 2 * ix + u; const bool v_ = t_ >= 0 && t_ < L_; const size_t r_ = (size_t)(rowbase_ + (v_ ? t_ : 0)); \
      rx[u] = *(const uint4*)(XC + r_ * DXBC + h_ * 64 + cc * 8); } \
    _Pragma("unroll") for (int u = 0; u < 4; ++u) { \
      const int t_ = tb_ + ib + 16 * u; const bool v_ = t_ >= 0 && t_ < L_; const size_t r_ = (size_t)(rowbase_ + (v_ ? t_ : 0)); \
      rb[u] = *(const uint4*)(XC + r_ * DXBC + 2048 + g_ * 128 + c16 * 8); rc[u] = *(const uint4*)(XC + r_ * DXBC + 2560 + g_ * 128 + c16 * 8); } \
    { const int t_ = tb_ + w * 16 + fr; const bool v_ = t_ >= 0 && t_ < L_; const size_t r_ = (size_t)(rowbase_ + (v_ ? t_ : 0)); \
      _Pragma("unroll") for (int m = 0; m < 4; ++m) rz[m] = *(const uint2*)(ZY + r_ * DSSM + h_ * 64 + m * 16 + fq * 4); } \
    if (w == 0) { const int t_ = tb_ + lane; const bool v_ = t_ >= 0 && t_ < L_; dtv = DT[(size_t)(rowbase_ + (v_ ? t_ : 0)) * 32 + h_]; } \
    if (samp) { const float* st_in = p.st_ssm + (size_t)(item0 + (k_)) * 64 * 128; \
      _Pragma("unroll") for (int m = 0; m < 4; ++m) _Pragma("unroll") for (int nn = 0; nn < 2; ++nn) _Pragma("unroll") for (int j = 0; j < 4; ++j) \
        hnext[m][nn][j] = __builtin_nontemporal_load(st_in + (m * 16 + fq * 4 + j) * 128 + w * 32 + nn * 16 + fr); } \
  } while (0)
#define SSD_FRESH() do { int t_ = tid; asm volatile("" : "+v"(t_)); tidx = t_; lane = tidx & 63; w = tidx >> 6; fr = lane & 15; fq = lane >> 4; \
                         cc = tidx & 7; ix = tidx >> 3; c16 = tidx & 15; ib = tidx >> 4; } while (0)
#pragma unroll
  for (int m = 0; m < 4; ++m)
#pragma unroll
    for (int nn = 0; nn < 2; ++nn) { hacc[m][nn] = f32x4{0.f, 0.f, 0.f, 0.f}; hnext[m][nn] = f32x4{0.f, 0.f, 0.f, 0.f}; }
  SSD_PREFETCH(0);
  __syncthreads();

  for (int c = 0; c < 33; ++c) {
    const bool active = c < nreal;
    int h = 0, rowbase = 0, tbase = 0, L = 0;
    SSD_STEP(c, h, rowbase, tbase, L);
    float a = 0.f, Dh = 0.f;
    if (active) {
      SSD_FRESH();
      a = s_al[h]; Dh = s_al[32 + h];
      if (samp) {
#pragma unroll
        for (int m = 0; m < 4; ++m)
#pragma unroll
          for (int nn = 0; nn < 2; ++nn) hacc[m][nn] = hnext[m][nn];
      }
#pragma unroll
      for (int m = 0; m < 4; ++m)
#pragma unroll
        for (int nn = 0; nn < 2; ++nn)
#pragma unroll
          for (int j = 0; j < 4; j += 2) {
            const unsigned pk = pack2(hacc[m][nn][j], hacc[m][nn][j + 1]);
            sH[(m * 16 + fq * 4 + j) * LDN + w * 32 + nn * 16 + fr] = (bf16_t)(pk & 0xffffu);
            sH[(m * 16 + fq * 4 + j + 1) * LDN + w * 32 + nn * 16 + fr] = (bf16_t)(pk >> 16);
          }
      if (w == 0) {
        { const int t_ = tbase + lane; if (!(t_ >= 0 && t_ < L)) dtv = 0.f; }
        float sc = dtv * a;
#pragma unroll
        for (int d = 1; d < 64; d <<= 1) {
          const float o = __shfl_up(sc, d);
          if (lane >= d) sc += o;
        }
        const float total = __shfl(sc, 63);
        s_dt[lane] = dtv;
        s_acs[lane] = sc;
        s_wt[lane] = dtv * __expf(total - sc);
      }
      if (!samp && c >= 1) {
        const unsigned x0[4] = {rx[0].x, rx[0].y, rx[0].z, rx[0].w}, x1[4] = {rx[1].x, rx[1].y, rx[1].z, rx[1].w};
#pragma unroll
        for (int e = 0; e < 4; ++e) {
          *(unsigned*)(sXT + (cc * 8 + 2 * e) * LDQ + 2 * ix) = (x0[e] & 0xffffu) | (x1[e] << 16);
          *(unsigned*)(sXT + (cc * 8 + 2 * e + 1) * LDQ + 2 * ix) = (x0[e] >> 16) | (x1[e] & 0xffff0000u);
        }
#pragma unroll
        for (int u = 0; u < 4; ++u) {
          const int i = ib + 16 * u;
          *(uint4*)(sB + i * LDN + c16 * 8) = rb[u];
          *(uint4*)(sC + i * LDN + c16 * 8) = rc[u];
        }
      } else {
        {
        const int t0_ = tbase + 2 * ix, t1_ = t0_ + 1;
        const unsigned m0_ = (t0_ >= 0 && t0_ < L) ? 0xffffffffu : 0u, m1_ = (t1_ >= 0 && t1_ < L) ? 0xffffffffu : 0u;
        const unsigned x0[4] = {rx[0].x & m0_, rx[0].y & m0_, rx[0].z & m0_, rx[0].w & m0_}, x1[4] = {rx[1].x & m1_, rx[1].y & m1_, rx[1].z & m1_, rx[1].w & m1_};
#pragma unroll
        for (int e = 0; e < 4; ++e) {
          *(unsigned*)(sXT + (cc * 8 + 2 * e) * LDQ + 2 * ix) = (x0[e] & 0xffffu) | (x1[e] << 16);
          *(unsigned*)(sXT + (cc * 8 + 2 * e + 1) * LDQ + 2 * ix) = (x0[e] >> 16) | (x1[e] & 0xffff0000u);
        }
      }
#pragma unroll
      for (int u = 0; u < 4; ++u) {
        const int i = ib + 16 * u;
        const int t_ = tbase + i;
        const unsigned mk_ = (t_ >= 0 && t_ < L) ? 0xffffffffu : 0u;
        *(uint4*)(sB + i * LDN + c16 * 8) = make_uint4(rb[u].x & mk_, rb[u].y & mk_, rb[u].z & mk_, rb[u].w & mk_);
        *(uint4*)(sC + i * LDN + c16 * 8) = make_uint4(rc[u].x & mk_, rc[u].y & mk_, rc[u].z & mk_, rc[u].w & mk_);
      }
      }
    }
    uint2 zc[4];
#pragma unroll
    for (int m = 0; m < 4; ++m) zc[m] = rz[m];
    if (c + 1 < nreal) SSD_PREFETCH(c + 1);
    __syncthreads();
    if (active && (!samp || w == 0)) {
      SSD_FRESH();
      f32x4 cb[4], y[4];
#pragma unroll
      for (int m = 0; m < 4; ++m) { cb[m] = f32x4{0.f, 0.f, 0.f, 0.f}; y[m] = f32x4{0.f, 0.f, 0.f, 0.f}; }
#pragma unroll
      for (int ks = 0; ks < 4; ++ks) {
        const bf16x8 cf = *(const bf16x8*)(sC + (w * 16 + fr) * LDN + ks * 32 + fq * 8);
        bf16x8 bb[4], hh[4];
#pragma unroll
        for (int m = 0; m < 4; ++m) {
          bb[m] = *(const bf16x8*)(sB + (m * 16 + fr) * LDN + ks * 32 + fq * 8);
          hh[m] = *(const bf16x8*)(sH + (m * 16 + fr) * LDN + ks * 32 + fq * 8);
        }
        __builtin_amdgcn_sched_barrier(0);
#pragma unroll
        for (int m = 0; m < 4; ++m) {
          cb[m] = MFMA16(bb[m], cf, cb[m]);
          y[m] = MFMA16(hh[m], cf, y[m]);
        }
        __builtin_amdgcn_sched_barrier(0);
      }
      {
        const int q = w * 16 + fr;
        const float aq = s_acs[q];
        const float eq = __expf(aq);
#pragma unroll
        for (int m = 0; m < 4; ++m) {
          const int s0 = m * 16 + fq * 4;
          const f32x4 as = *(const f32x4*)(s_acs + s0), ds = *(const f32x4*)(s_dt + s0);
          float v[4];
#pragma unroll
          for (int j = 0; j < 4; ++j) {
            const int sidx = s0 + j;
            float val = (sidx <= q) ? cb[m][j] * __expf(aq - as[j]) * ds[j] : 0.f;
            if (sidx == q) val += Dh;
            v[j] = val;
          }
          uint2 pk; pk.x = pack2(v[0], v[1]); pk.y = pack2(v[2], v[3]);
          *(uint2*)(sG + q * LDQ + s0) = pk;
          y[m] *= eq;
        }
      }
      SSD_FRESH();
      {
        bf16x8 gf[2], xf[2][4];
#pragma unroll
        for (int ks = 0; ks < 2; ++ks) {
          gf[ks] = *(const bf16x8*)(sG + (w * 16 + fr) * LDQ + ks * 32 + fq * 8);
#pragma unroll
          for (int m = 0; m < 4; ++m) xf[ks][m] = *(const bf16x8*)(sXT + (m * 16 + fr) * LDQ + ks * 32 + fq * 8);
        }
        __builtin_amdgcn_sched_barrier(0);
#pragma unroll
        for (int ks = 0; ks < 2; ++ks)
#pragma unroll
          for (int m = 0; m < 4; ++m) y[m] = MFMA16(xf[ks][m], gf[ks], y[m]);
      }
      __builtin_amdgcn_sched_barrier(0);
      SSD_FRESH();
      {
        const int t = tbase + w * 16 + fr;
        const bool valid = t >= 0 && t < L;
        bf16_t* yrow = ZY + (size_t)(rowbase + (valid ? t : 0)) * DSSM + h * 64 + fq * 4;
        float part = 0.f;
#pragma unroll
        for (int m = 0; m < 4; ++m) {
          const float z0 = bflo(zc[m].x), z1 = bfhi(zc[m].x), z2 = bflo(zc[m].y), z3 = bfhi(zc[m].y);
          const float y0 = y[m][0] * siluf_(z0), y1 = y[m][1] * siluf_(z1), y2 = y[m][2] * siluf_(z2), y3 = y[m][3] * siluf_(z3);
          part += y0 * y0 + y1 * y1 + y2 * y2 + y3 * y3;
          uint2 pk; pk.x = pack2(y0, y1); pk.y = pack2(y2, y3);
          if (valid && !dry) *(uint2*)(yrow + m * 16) = pk;
        }
        part += __shfl_xor(part, 16); part += __shfl_xor(part, 32);
        if (fq == 0 && valid && !dry) WSF(p, ssq)[(size_t)(rowbase + t) * 32 + h] = part;
      }
    }
    if (active) {
      SSD_FRESH();
      {
        const float cd = __expf(s_acs[63]);
#pragma unroll
        for (int m = 0; m < 4; ++m)
#pragma unroll
          for (int nn = 0; nn < 2; ++nn) hacc[m][nn] *= cd;
#pragma unroll
        for (int ks = 0; ks < 2; ++ks) {
          if (samp && ks == 1) break;
          bf16x8 bfr[2];
          const f32x4 wt0 = *(const f32x4*)(s_wt + ks * 32 + fq * 8), wt1 = *(const f32x4*)(s_wt + ks * 32 + fq * 8 + 4);
#pragma unroll
          for (int nn = 0; nn < 2; ++nn) {
            unsigned pw[4];
#pragma unroll
            for (int jj = 0; jj < 8; jj += 2) {
              const int sidx = ks * 32 + fq * 8 + jj;
              const float b0 = bf2f(sB[sidx * LDN + w * 32 + nn * 16 + fr]) * (jj < 4 ? wt0[jj & 3] : wt1[jj & 3]);
              const float b1 = bf2f(sB[(sidx + 1) * LDN + w * 32 + nn * 16 + fr]) * (jj < 4 ? wt0[(jj + 1) & 3] : wt1[(jj + 1) & 3]);
              pw[jj >> 1] = pack2(b0, b1);
            }
            typedef unsigned u32x4_t __attribute__((ext_vector_type(4)));
            const u32x4_t pv = {pw[0], pw[1], pw[2], pw[3]};
            bfr[nn] = __builtin_bit_cast(bf16x8, pv);
          }
          bf16x8 af[4];
#pragma unroll
          for (int m = 0; m < 4; ++m) af[m] = *(const bf16x8*)(sXT + (m * 16 + fr) * LDQ + ks * 32 + fq * 8);
          __builtin_amdgcn_sched_barrier(0);
#pragma unroll
          for (int m = 0; m < 4; ++m)
#pragma unroll
            for (int nn = 0; nn < 2; ++nn) hacc[m][nn] = MFMA16(af[m], bfr[nn], hacc[m][nn]);
        }
      }
      if (samp && !dry) {
        float* st_out = p.out + OFF_SS + (size_t)(item0 + c) * 64 * 128;
#pragma unroll
        for (int m = 0; m < 4; ++m)
#pragma unroll
          for (int nn = 0; nn < 2; ++nn)
#pragma unroll
            for (int j = 0; j < 4; ++j) __builtin_nontemporal_store(hacc[m][nn][j], st_out + (m * 16 + fq * 4 + j) * 128 + w * 32 + nn * 16 + fr);
      }
    }
    if (samp && !active && !dry) ua_slice(p, (int)blockIdx.x * 17 + (c - 16), (int)gridDim.x * 17, tid);
    __syncthreads();
  }
  if (!samp && !dry) {
    float* st_out = p.out + OFF_PS + (size_t)item0 * 64 * 128;
#pragma unroll
    for (int m = 0; m < 4; ++m)
#pragma unroll
      for (int nn = 0; nn < 2; ++nn)
#pragma unroll
        for (int j = 0; j < 4; ++j) st_out[(m * 16 + fq * 4 + j) * 128 + w * 32 + nn * 16 + fr] = hacc[m][nn][j];
  }
  __builtin_amdgcn_s_setprio(0);
#undef SSD_PREFETCH
#undef SSD_FRESH
#undef SSD_STEP
}

DI void phase_elementwise(const Params& p) {
  const int tidq = opaque_tid();
  const int gt = blockIdx.x * NTHREADS + tidq, gn = gridDim.x * NTHREADS;
  bf16_t* Y = WSB(p, R0);
  const float* ssq = WSF(p, ssq);
  {
    const int cc = gt & 255, g = cc >> 6;
    constexpr int NI = MTOT;
    const int rstep = gn >> 8;
    for (int row0 = gt >> 8; row0 < NI; row0 += 4 * rstep) {
      uint4 u[4]; float4 s0[4], s1[4];
#pragma unroll
      for (int k = 0; k < 4; ++k) {
        const int row = row0 + k * rstep;
        if (row < NI) {
          u[k] = *(const uint4*)(Y + (size_t)row * DSSM + cc * 8);
          s0[k] = *(const float4*)(ssq + (size_t)row * 32 + g * 8); s1[k] = *(const float4*)(ssq + (size_t)row * 32 + g * 8 + 4);
        }
      }
#pragma unroll
      for (int k = 0; k < 4; ++k) {
        const int row = row0 + k * rstep;
        if (row < NI) {
          const float ss = s0[k].x + s0[k].y + s0[k].z + s0[k].w + s1[k].x + s1[k].y + s1[k].z + s1[k].w;
          const float rs = rsqrtf(ss * (1.f / 512.f) + EPS);
          uint4 o;
          o.x = pack2(bflo(u[k].x) * rs, bfhi(u[k].x) * rs);
          o.y = pack2(bflo(u[k].y) * rs, bfhi(u[k].y) * rs);
          o.z = pack2(bflo(u[k].z) * rs, bfhi(u[k].z) * rs);
          o.w = pack2(bflo(u[k].w) * rs, bfhi(u[k].w) * rs);
          *(uint4*)(Y + (size_t)row * DSSM + cc * 8) = o;
        }
      }
    }
  }
}

DI void phase_prep(const Params& p, char* smem) {
  const int tidq = opaque_tid();
  if (blockIdx.x == 0 && tidq < 4) ((int*)(p.ws + O_counter))[tidq] = 0;
  const int lane = tidq & 63, wid = tidq >> 6;
  bf16_t* XB = WSB(p, R1);
  for (int row0 = blockIdx.x * 8 + wid; row0 < MTOT; row0 += gridDim.x * 16) {
    float4 v[2][4];
#pragma unroll
    for (int q = 0; q < 2; ++q) {
      const int row = row0 + q * gridDim.x * 8;
      if (row < MTOT) {
        const float* xr = xrow_ptr(p.x_prompt, p.x_sample, p.meta, row);
#pragma unroll
        for (int i = 0; i < 4; ++i) v[q][i] = *(const float4*)(xr + i * 256 + lane * 4);
      }
    }
#pragma unroll
    for (int q = 0; q < 2; ++q) {
      const int row = row0 + q * gridDim.x * 8;
      float ss = 0.f;
      if (row < MTOT) {
#pragma unroll
        for (int i = 0; i < 4; ++i) {
          ss += v[q][i].x * v[q][i].x + v[q][i].y * v[q][i].y + v[q][i].z * v[q][i].z + v[q][i].w * v[q][i].w;
          uint2 o;
          o.x = pack2(v[q][i].x, v[q][i].y);
          o.y = pack2(v[q][i].z, v[q][i].w);
          *(uint2*)(XB + (size_t)row * DM + i * 256 + lane * 4) = o;
        }
      }
#pragma unroll
      for (int d = 1; d < 64; d <<= 1) ss += __shfl_xor(ss, d);
      if (lane == 0 && row < MTOT) WSF(p, ss0)[row] = ss;
    }
  }
  convert_weight(p.w_gu1, p.norm_ffn1, WSB(p, wt_gu1), DM, 2 * DFF, 2 * DFF, 1, smem, (int)blockIdx.x, (int)gridDim.x);
  convert_weight(p.w_in, p.norm_mix, WSB(p, wt_in), DM, 10272, NIN, 2, smem, (int)blockIdx.x, (int)gridDim.x, 0, (int)gridDim.x == 256 ? 408 : (1 << 30));
}

DI void convert_idle(const Params& p, char* smem, int which, int first, int count) {
  const int c = unit_c(smem);
  int rank = c - first, nr = count;
  if ((int)gridDim.x != 256) { rank = (int)blockIdx.x; nr = (int)gridDim.x; }
  else if (rank < 0 || rank >= count) return;
  if (which == 0) {
    convert_weight(p.w_down1, nullptr, WSB(p, wt_down1), DFF, DM, DM, 0, smem, rank, nr);
    if ((int)gridDim.x == 256) convert_weight(p.w_in, p.norm_mix, WSB(p, wt_in), DM, 10272, NIN, 2, smem, rank, nr, 408);
  }
  if (which == 1) {
    convert_weight(p.w_a_out, nullptr, WSB(p, wt_aout), DM, DM, DM, 0, smem, rank, nr);
    convert_weight(p.w_b_out, p.ssm_norm_w, WSB(p, wt_bout), DSSM, DM, DM, 0, smem, rank, nr);
    convert_weight(p.w_o, nullptr, WSB(p, wt_o), DM, DM, DM, 0, smem, rank, nr);
  }
  if (which == 2) convert_weight(p.w_gu2, p.norm_ffn2, WSB(p, wt_gu2), DM, 2 * DFF, 2 * DFF, 1, smem, rank, nr);
  if (which == 3) convert_weight(p.w_down2, nullptr, WSB(p, wt_down2), DFF, DM, DM, 0, smem, rank, nr);
}

DI void phase_final(const Params& p) {
  const int tidq = opaque_tid();
  const int lane = tidq & 63, wid = tidq >> 6;
  const int rstep = gridDim.x * 8;
  float4 wv[4];
#pragma unroll
  for (int i = 0; i < 4; ++i) wv[i] = *(const float4*)(p.norm_final + i * 256 + lane * 4);
  for (int row0 = blockIdx.x * 8 + wid; row0 < TAIL_ROW0; row0 += 2 * rstep) {
    float4 v[2][4]; float sp[2]; float* o[2];
#pragma unroll
    for (int q = 0; q < 2; ++q) {
      const int row = row0 + q * rstep;
      o[q] = nullptr; sp[q] = 0.f;
      if (row < TAIL_ROW0) {
        if (row < MP) {
          const int b = row / LP, t = row - b * LP;
          if (t >= 16) o[q] = p.out + OFF_YP + ((size_t)b * 2048 + (t - 16)) * DM;
        } else {
          o[q] = p.out + OFF_YS + (size_t)(row - MP) * DM;
        }
        if (o[q]) {
          if (lane < 16) sp[q] = WSF(p, ssp)[(size_t)row * 16 + lane];
#pragma unroll
          for (int i = 0; i < 4; ++i) v[q][i] = *(const float4*)(WSF(p, H) + (size_t)row * DM + i * 256 + lane * 4);
        }
      }
    }
#pragma unroll
    for (int q = 0; q < 2; ++q) {
      float s = sp[q];
      s += __shfl_xor(s, 1); s += __shfl_xor(s, 2); s += __shfl_xor(s, 4); s += __shfl_xor(s, 8);
      s = __shfl(s, 0);
      if (o[q]) {
        const float rs = rsqrtf(s * (1.f / DM) + EPS);
#pragma unroll
        for (int i = 0; i < 4; ++i) {
          float4 r;
          r.x = v[q][i].x * rs * wv[i].x; r.y = v[q][i].y * rs * wv[i].y; r.z = v[q][i].z * rs * wv[i].z; r.w = v[q][i].w * rs * wv[i].w;
          { const f32x4 rv = {r.x, r.y, r.z, r.w}; __builtin_nontemporal_store(rv, (f32x4*)(o[q] + i * 256 + lane * 4)); }
        }
      }
    }
  }
  {
    const float* slab = (const float*)WSB(p, XBC);
    for (int row = TAIL_ROW0 + blockIdx.x * 8 + wid; row < MTOT; row += gridDim.x * 8) {
      float* o = row < MP ? p.out + OFF_YP + ((size_t)(row / LP) * 2048 + (row % LP - 16)) * DM : p.out + OFF_YS + (size_t)(row - MP) * DM;
      f32x4 h[4];
      float ss = 0.f;
#pragma unroll
      for (int i = 0; i < 4; ++i) {
        const int col = i * 256 + lane * 4;
        f32x4 pv[11];
#pragma unroll
        for (int k = 0; k < 11; ++k) pv[k] = *(const f32x4*)(slab + ((size_t)k * 768 + (row - TAIL_ROW0)) * DM + col);
        f32x4 a = {0.f, 0.f, 0.f, 0.f};
#pragma unroll
        for (int k = 0; k < 11; ++k) a += pv[k];
        h[i] = *(const f32x4*)(WSF(p, H) + (size_t)row * DM + col) + a * 0.5f;
        ss += h[i][0] * h[i][0] + h[i][1] * h[i][1] + h[i][2] * h[i][2] + h[i][3] * h[i][3];
      }
#pragma unroll
      for (int d = 1; d < 64; d <<= 1) ss += __shfl_xor(ss, d);
      const float rs = rsqrtf(ss * (1.f / DM) + EPS);
#pragma unroll
      for (int i = 0; i < 4; ++i) {
        const f32x4 r = {h[i][0] * rs * wv[i].x, h[i][1] * rs * wv[i].y, h[i][2] * rs * wv[i].z, h[i][3] * rs * wv[i].w};
        *(f32x4*)(o + i * 256 + lane * 4) = r;
      }
    }
  }
}

typedef const __attribute__((address_space(4))) Params* KParamsPtr;
DI Params load_params() {
  KParamsPtr kp = (KParamsPtr)__builtin_amdgcn_kernarg_segment_ptr();
  asm volatile("" : "+s"(kp));
  Params q;
  q.x_prompt = kp->x_prompt; q.x_sample = kp->x_sample; q.st_conv_a = kp->st_conv_a; q.st_ssm_conv = kp->st_ssm_conv; q.st_ssm = kp->st_ssm; q.meta = kp->meta;
  q.norm_ffn1 = kp->norm_ffn1; q.w_gu1 = kp->w_gu1; q.w_down1 = kp->w_down1; q.norm_mix = kp->norm_mix; q.w_in = kp->w_in; q.conv_a_w = kp->conv_a_w;
  q.w_a_out = kp->w_a_out; q.ssm_conv_w = kp->ssm_conv_w; q.ssm_conv_b = kp->ssm_conv_b; q.dt_bias = kp->dt_bias; q.a_log = kp->a_log; q.d_skip = kp->d_skip;
  q.ssm_norm_w = kp->ssm_norm_w; q.w_b_out = kp->w_b_out; q.w_o = kp->w_o; q.norm_ffn2 = kp->norm_ffn2; q.w_gu2 = kp->w_gu2; q.w_down2 = kp->w_down2;
  q.norm_final = kp->norm_final; q.out = kp->out; q.ws = kp->ws;
  return q;
}

#ifndef PH_MASK
#define PH_MASK 0xFFFF
#endif
#ifndef REP_MASK
#define REP_MASK 0
#endif
#define PH(k) if constexpr ((PH_MASK >> (k)) & 1)
#define REP(k) for (int rep_ = (((REP_MASK >> (k)) & 1) ? 0 : 1); rep_ < 2; ++rep_)
#define GRID_BARRIER() do { const Params pb_ = load_params(); XcdBarrier xb_; xb_.bar = (unsigned*)(pb_.ws + O_bar); xb_.x = xb_xcc_id(); \
    xb_.st = (volatile LAS unsigned*)(smem + SITEM_OFF + 16); xcd_barrier(xb_); } while (0)
__global__ void __launch_bounds__(NTHREADS) hybrid_fwd(Params p_unused) {
  extern __shared__ __attribute__((aligned(16))) char smem[];
  cg::grid_group grid = cg::this_grid();
  unsigned* bar; { const Params p = load_params(); bar = (unsigned*)(p.ws + O_bar); }
  volatile LAS unsigned* xb_st = (volatile LAS unsigned*)(smem + SITEM_OFF + 16);
  int* s_c = (int*)(smem + SITEM_OFF + 32);
  if (threadIdx.x == 0) { xb_st[0] = 0u; xb_st[1] = 0u; }
  __syncthreads();
  { const XcdBarrier xb0 = xcd_barrier_post(bar, xb_st);
    if (threadIdx.x == 0) s_c[0] = (int)xb_add(&bar[XCD_BAR_WORDS + 64 * xb0.x], 1u); }
  REP(0) { PH(0) { const Params p = load_params(); phase_prep(p, smem); }
  GRID_BARRIER(); }
  if (bar == nullptr) grid.sync();
  if (threadIdx.x == 0) {
    bool even = (gridDim.x & 7) == 0;
    for (unsigned j = 0; j < 8; ++j) even = even && (xb_ld(&bar[XCD_BAR_WORDS + 64 * j]) == gridDim.x / 8);
    s_c[1] = even ? (int)(xb_xcc_id() + 8u * (unsigned)s_c[0]) : (int)blockIdx.x;
  }
  __syncthreads();
  REP(1) { PH(1) { const Params p = load_params(); {
    pg8::EpiSwiglu<1> E{WSB(p, R0), WSF(p, ss0)};
    run_gemm(smem, WSB(p, R1), WSB(p, wt_gu1), 2 * DFF, DM, E);
    convert_idle(p, smem, 0, 194, 62);
  } }
  GRID_BARRIER(); }
  PH(2) { const Params p = load_params();
    pg8::EpiDown E{p.x_prompt, p.x_sample, p.meta, WSF(p, H), 1, 0.5f, WSB(p, R1), WSF(p, ssp)};
    run_gemm_panel(smem, WSB(p, R0), WSB(p, wt_down1), DM, DFF, E);
    run_gemm_tail(smem, WSB(p, R0), WSB(p, wt_down1), DM, DFF, 11, (float*)WSB(p, XBC));
    convert_idle(p, smem, 1, 132, 124);
  }
  GRID_BARRIER();
  PH(2) { const Params p = load_params(); fixup_down<11>(p, true, 0.5f, WSB(p, R1)); }
  GRID_BARRIER();
  REP(3) { PH(3) { const Params p = load_params(); {
    pg8::EpiInproj E{WSF(p, rsv), p.out, p.ws, p.dt_bias};
    run_gemm(smem, WSB(p, R1), WSB(p, wt_in), NIN, DM, E);
    convert_idle(p, smem, 2, 187, 69);
  } }
  GRID_BARRIER(); }
  PH(11) { const Params p = load_params(); phase_conv(p); }
  GRID_BARRIER();
  REP(4) { PH(4) { const Params p = load_params(); { int dry = (rep_ == 0); asm volatile("" : "+s"(dry)); phase_ssd(p, smem, dry); } }
  GRID_BARRIER(); }
  PH(5) { const Params p = load_params(); phase_elementwise(p); }
  GRID_BARRIER();
  PH(6) { const Params p = load_params();
    pg8::EpiGate<false> E1{WSB(p, AB), WSB(p, SGA)};
    run_gemm_panel(smem, WSB(p, R1), WSB(p, wt_aout), DM, DM, E1);
    pg8::EpiGate<true> E2{WSB(p, AB), WSB(p, SGB)};
    run_gemm_panel(smem, WSB(p, R0), WSB(p, wt_bout), DM, DSSM, E2);
    run_gemm_tail(smem, WSB(p, R1), WSB(p, wt_aout), DM, DM, 4, (float*)WSB(p, XBC), 96);
    run_gemm_tail(smem, WSB(p, R0), WSB(p, wt_bout), DM, DSSM, 8, (float*)WSB(p, XBC) + (size_t)4 * 768 * DM);
  }
  GRID_BARRIER();
  PH(6) { const Params p = load_params(); fixup_merge(p); }
  GRID_BARRIER();
  PH(7) { const Params p = load_params();
    pg8::EpiDown E{p.x_prompt, p.x_sample, p.meta, WSF(p, H), 0, 1.0f, WSB(p, R1), WSF(p, ssp)};
    run_gemm_panel(smem, WSB(p, AB), WSB(p, wt_o), DM, DM, E);
    run_gemm_tail(smem, WSB(p, AB), WSB(p, wt_o), DM, DM, 4, (float*)WSB(p, XBC));
  }
  GRID_BARRIER();
  PH(7) { const Params p = load_params(); fixup_down<4>(p, false, 1.0f, WSB(p, R1)); }
  GRID_BARRIER();
  REP(8) { PH(8) { const Params p = load_params(); {
    pg8::EpiSwiglu<0> E{WSB(p, R0), WSF(p, rsv)};
    run_gemm(smem, WSB(p, R1), WSB(p, wt_gu2), 2 * DFF, DM, E);
    convert_idle(p, smem, 3, 194, 62);
  } }
  GRID_BARRIER(); }
  PH(9) { const Params p = load_params();
    pg8::EpiDown E{p.x_prompt, p.x_sample, p.meta, WSF(p, H), 0, 0.5f, nullptr, WSF(p, ssp)};
    run_gemm_panel(smem, WSB(p, R0), WSB(p, wt_down2), DM, DFF, E);
    run_gemm_tail(smem, WSB(p, R0), WSB(p, wt_down2), DM, DFF, 11, (float*)WSB(p, XBC));
  }
  GRID_BARRIER();
  REP(10) { PH(10) { const Params p = load_params(); phase_final(p); } if (rep_ == 0) GRID_BARRIER(); }
}

extern "C" void kernel_launch(void* const* d_in, const int* in_sizes, int n_in, void* d_out, int out_size, void* d_ws, size_t ws_size,
                              hipStream_t stream) {
  static int grid_blocks = 0;
  if (!grid_blocks) {
    int dev = 0, cus = 0, per_cu = 0;
    (void)hipGetDevice(&dev);
    (void)hipDeviceGetAttribute(&cus, hipDeviceAttributeMultiprocessorCount, dev);
    (void)hipFuncSetAttribute((const void*)hybrid_fwd, hipFuncAttributeMaxDynamicSharedMemorySize, LDS_BYTES);
    (void)hipOccupancyMaxActiveBlocksPerMultiprocessor(&per_cu, (const void*)hybrid_fwd, NTHREADS, LDS_BYTES);
    if (per_cu < 1) { fprintf(stderr, "kernel_launch: occupancy query reports %d blocks per CU\n", per_cu); per_cu = 1; }
    grid_blocks = 256;
    if (cus < 256) fprintf(stderr, "kernel_launch: %d CUs < 256: the cooperative launch will be refused\n", cus);
    fprintf(stderr, "kernel_launch: cus=%d per_cu=%d grid=%d ws=%zu\n", cus, per_cu, grid_blocks, ws_size);
  }
  Params p{};
  const float* const* in = (const float* const*)d_in;
  p.x_prompt = in[0]; p.x_sample = in[1]; p.st_conv_a = in[2]; p.st_ssm_conv = in[3]; p.st_ssm = in[4]; p.meta = in[5];
  p.norm_ffn1 = in[6]; p.w_gu1 = in[7]; p.w_down1 = in[8]; p.norm_mix = in[9]; p.w_in = in[10]; p.conv_a_w = in[11];
  p.w_a_out = in[12]; p.ssm_conv_w = in[13]; p.ssm_conv_b = in[14]; p.dt_bias = in[15]; p.a_log = in[16]; p.d_skip = in[17];
  p.ssm_norm_w = in[18]; p.w_b_out = in[19]; p.w_o = in[20]; p.norm_ffn2 = in[21]; p.w_gu2 = in[22]; p.w_down2 = in[23];
  p.norm_final = in[24];
  p.out = (float*)d_out;
  p.ws = (char*)d_ws;
  if (WS_END > ws_size) { fprintf(stderr, "kernel_launch: workspace too small: need %zu have %zu\n", (size_t)WS_END, ws_size); return; }
  (void)hipMemsetAsync((char*)d_ws + O_bar, 0, BAR_BYTES, stream);
  void* args[] = {&p};
  hipError_t e = hipLaunchCooperativeKernel((const void*)hybrid_fwd, dim3(grid_blocks), dim3(NTHREADS), args, LDS_BYTES, stream);
  if (e != hipSuccess) fprintf(stderr, "cooperative launch failed: %s (grid %d)\n", hipGetErrorString(e), grid_blocks);
}
```

```cpp
#include <hip/hip_runtime.h>
#include <hip/hip_cooperative_groups.h>
#include <cstdio>
#include <cstdint>
namespace cg = cooperative_groups;

typedef unsigned short bf16_t;
using bf16x8 = __attribute__((ext_vector_type(8))) short;
using f32x4 = __attribute__((ext_vector_type(4))) float;
#define DI __device__ __forceinline__
#define MFMA16(a, b, c) __builtin_amdgcn_mfma_f32_16x16x32_bf16((a), (b), (c), 0, 0, 0)

constexpr int MP = 16512, MS = 512, MTOT = 17024, LP = 2064, MPAD = 17152;
constexpr int DM = 1024, DFF = 2816, DSSM = 2048, DXBC = 3072, NIN = 10496;
constexpr float EPS = 1e-6f;
constexpr int NTHREADS = 512;
constexpr int RS_LDS_OFF = 131072;
constexpr int SSD_HALF_BYTES = 71680;
constexpr int SITEM_OFF = 2 * SSD_HALF_BYTES;
constexpr int LDS_BYTES = SITEM_OFF + 1024;
constexpr size_t OFF_YP = 0;
constexpr size_t OFF_YS = OFF_YP + (size_t)8 * 2048 * 1024;
constexpr size_t OFF_PCA = OFF_YS + (size_t)128 * 4 * 1024;
constexpr size_t OFF_PSC = OFF_PCA + (size_t)8 * 2 * 1024;
constexpr size_t OFF_PS = OFF_PSC + (size_t)8 * 3 * 3072;
constexpr size_t OFF_SCA = OFF_PS + (size_t)8 * 32 * 64 * 128;
constexpr size_t OFF_SSC = OFF_SCA + (size_t)128 * 2 * 1024;
constexpr size_t OFF_SS = OFF_SSC + (size_t)128 * 3 * 3072;

struct Params {
  const float *x_prompt, *x_sample, *st_conv_a, *st_ssm_conv, *st_ssm, *meta;
  const float *norm_ffn1, *w_gu1, *w_down1, *norm_mix, *w_in, *conv_a_w, *w_a_out, *ssm_conv_w, *ssm_conv_b, *dt_bias, *a_log,
      *d_skip, *ssm_norm_w, *w_b_out, *w_o, *norm_ffn2, *w_gu2, *w_down2, *norm_final;
  float* out;
  char* ws;
};

constexpr size_t al256(size_t x) { return (x + 255) & ~(size_t)255; }
constexpr size_t O_wt_gu1 = 0;
constexpr size_t O_wt_down1 = O_wt_gu1 + al256((size_t)2 * DFF * DM * 2);
constexpr size_t O_wt_in = O_wt_down1 + al256((size_t)DM * DFF * 2);
constexpr size_t O_wt_aout = O_wt_in + al256((size_t)NIN * DM * 2);
constexpr size_t O_wt_bout = O_wt_aout + al256((size_t)DM * DM * 2);
constexpr size_t O_wt_o = O_wt_bout + al256((size_t)DM * DSSM * 2);
constexpr size_t O_wt_gu2 = O_wt_o + al256((size_t)DM * DM * 2);
constexpr size_t O_wt_down2 = O_wt_gu2 + al256((size_t)2 * DFF * DM * 2);
constexpr size_t O_R0 = O_wt_down2 + al256((size_t)DM * DFF * 2);
constexpr size_t O_R1 = O_R0 + al256((size_t)MPAD * DFF * 2);
constexpr size_t O_AB = O_R1 + al256((size_t)MPAD * DM * 2);
constexpr size_t O_CH = O_AB + al256((size_t)MPAD * DM * 2);
constexpr size_t O_XBC = O_CH + al256((size_t)MTOT * DM * 2);
constexpr size_t O_SGA = O_XBC + al256((size_t)MTOT * DXBC * 2);
constexpr size_t O_SGB = O_SGA + al256((size_t)MTOT * DM * 2);
constexpr size_t O_H = O_SGB + al256((size_t)MTOT * DM * 2);
constexpr size_t O_DT = O_H + al256((size_t)MTOT * DM * 4);
constexpr size_t O_ss0 = O_DT + al256((size_t)MTOT * 32 * 4);
constexpr size_t O_ssp = O_ss0 + al256((size_t)MTOT * 4);
constexpr size_t O_ssq = O_ssp + al256((size_t)MTOT * 16 * 4);
constexpr size_t O_rsv = O_ssq + al256((size_t)MTOT * 32 * 4);
constexpr size_t O_counter = O_rsv + al256((size_t)MTOT * 4);
constexpr size_t O_HALO = O_counter + 256;
constexpr size_t O_bar = O_HALO + al256((size_t)8 * 34 * 3 * DXBC * 2);
constexpr size_t BAR_BYTES = (3456 + 16 * 64) * 4;
constexpr size_t WS_END = O_bar + al256(BAR_BYTES);
#define WSB(p, name) ((bf16_t*)((p).ws + O_##name))
#define WSF(p, name) ((float*)((p).ws + O_##name))

typedef __bf16 bf16x2_t __attribute__((ext_vector_type(2)));
typedef float f32x2_t __attribute__((ext_vector_type(2)));
DI unsigned pack2(float a, float b) { f32x2_t v = {a, b}; bf16x2_t r = __builtin_convertvector(v, bf16x2_t); return __builtin_bit_cast(unsigned, r); }
DI unsigned short f2bf(float f) { return (unsigned short)(pack2(f, f) & 0xffffu); }
DI float bf2f(unsigned short b) { return __uint_as_float(((unsigned)b) << 16); }
DI float bflo(unsigned u) { return __uint_as_float(u << 16); }
DI float bfhi(unsigned u) { return __uint_as_float(u & 0xffff0000u); }
DI int opaque_tid() { int t = (int)threadIdx.x; asm volatile("" : "+v"(t)); return t; }
DI float fast_exp(float x) { return __builtin_amdgcn_exp2f(x * 1.44269504f); }
DI float sigmoidf_(float x) { return __builtin_amdgcn_rcpf(1.f + fast_exp(-x)); }
DI float siluf_(float x) { return x * __builtin_amdgcn_rcpf(1.f + fast_exp(-x)); }

DI const float* xrow_ptr(const float* x_prompt, const float* x_sample, const float* meta, int row) {
  if (row < MP) {
    int b = row / LP, t = row - b * LP;
    return t < 16 ? meta + (size_t)t * DM : x_prompt + ((size_t)b * 2048 + (t - 16)) * DM;
  }
  return x_sample + (size_t)(row - MP) * DM;
}

#define XB_TMO      128
#define XB_XCNT(j)  (256  + 64 * (j))
#define XB_XSUB(j)  (1280 + 64 * (j))
#define XB_XGEN(j)  (2304 + 64 * (j))
#define XB_TOP      3328
#define XB_TOPGEN   3392
#define XCD_BAR_WORDS 3456
#define XB_SPIN_CAP (1u << 18)
#define LAS __attribute__((address_space(3)))

__device__ __forceinline__ unsigned xb_ld(unsigned* p)              { return __hip_atomic_load(p, __ATOMIC_RELAXED, __HIP_MEMORY_SCOPE_AGENT); }
__device__ __forceinline__ unsigned xb_add(unsigned* p, unsigned v) { return __hip_atomic_fetch_add(p, v, __ATOMIC_RELAXED, __HIP_MEMORY_SCOPE_AGENT); }
__device__ __forceinline__ unsigned xb_xcc_id() { return (unsigned)__builtin_amdgcn_s_getreg((3 << 11) | 20) & 0xFu; }
#define XB_SPIN(cond, bar) do { unsigned _sp = 0; while (cond) { __builtin_amdgcn_s_sleep(1); \
    if ((++_sp & 255u) == 0u) { if (xb_ld(&(bar)[XB_TMO])) break; if (_sp > XB_SPIN_CAP) { atomicAdd(&(bar)[XB_TMO], 1u); break; } } } } while (0)

struct XcdBarrier {
    unsigned* bar; unsigned x;
    volatile LAS unsigned* st;
};

__device__ __forceinline__ XcdBarrier xcd_barrier_post(unsigned* bar, volatile LAS unsigned* st) {
    XcdBarrier b; b.bar = bar; b.x = xb_xcc_id(); b.st = st;
    if (threadIdx.x == 0) (void)xb_add(&bar[XB_XCNT(b.x)], 1u);
    return b;
}
__device__ __forceinline__ void xcd_barrier_complete(unsigned* bar, unsigned x, unsigned& nloc, unsigned& nx) {
    const unsigned G = gridDim.x * gridDim.y * gridDim.z;
    unsigned sum, cnt, mine, sp = 0u;
    for (;;) {
        sum = 0u; cnt = 0u; mine = 0u;
#pragma unroll
        for (unsigned j = 0; j < 16; ++j) { const unsigned c = xb_ld(&bar[XB_XCNT(j)]); sum += c; cnt += (c > 0u) ? 1u : 0u; mine = (j == x) ? c : mine; }
        if (sum == G) break;
        __builtin_amdgcn_s_sleep(1);
        if ((++sp & 255u) == 0u) { if (xb_ld(&bar[XB_TMO])) break; if (sp > XB_SPIN_CAP) { atomicAdd(&bar[XB_TMO], 1u); break; } }
    }
    nloc = mine > 0u ? mine : 1u; nx = cnt > 0u ? cnt : 1u;
}

__device__ __forceinline__ void xcd_barrier(const XcdBarrier& b) {
    asm volatile("s_waitcnt vmcnt(0)" ::: "memory");
    __syncthreads();
    if (threadIdx.x == 0) {
        unsigned* bar = b.bar;
        __builtin_amdgcn_s_waitcnt(0);
        unsigned nloc = b.st[0], nx = b.st[1];
        if (nloc == 0u) { xcd_barrier_complete(bar, b.x, nloc, nx); b.st[0] = nloc; b.st[1] = nx; }
        const unsigned old = xb_add(&bar[XB_XSUB(b.x)], 1u);
        const unsigned gen = old / nloc;
        if (old + 1u == (gen + 1u) * nloc) {
            __builtin_amdgcn_fence(__ATOMIC_RELEASE, "agent");
            asm volatile("s_waitcnt vmcnt(0)" ::: "memory");
            const unsigned og = xb_add(&bar[XB_TOP], 1u);
            const unsigned tg = og / nx;
            if (og + 1u == (tg + 1u) * nx) xb_add(&bar[XB_TOPGEN], 1u);
            else XB_SPIN(xb_ld(&bar[XB_TOPGEN]) == tg, bar);
            __builtin_amdgcn_fence(__ATOMIC_ACQUIRE, "agent");
            xb_add(&bar[XB_XGEN(b.x)], 1u);
            asm volatile("s_waitcnt vmcnt(0)" ::: "memory");
        } else {
            XB_SPIN(xb_ld(&bar[XB_XGEN(b.x)]) == gen, bar);
            __builtin_amdgcn_fence(__ATOMIC_ACQUIRE, "agent");
            asm volatile("s_waitcnt vmcnt(0)" ::: "memory");
        }
    }
    __syncthreads();
}


DI int colmap(int mode, int n) {
  if (mode == 0) return n;
  const int pn = n >> 8, bj = (n >> 7) & 1, i = n & 127;
  if (mode == 1) return bj * DFF + 128 * pn + i;
  if (n < 2048) return (bj ? 2048 : 1024) + 128 * pn + i;
  if (n < 3072) return n - 2048;
  if (n < 8192) return n;
  if (n < 10240) return n + 32;
  if (n < 10272) return n - 2048;
  return -1;
}

DI void convert_weight(const float* __restrict__ src, const float* __restrict__ kscale, bf16_t* __restrict__ dst, int K, int Nsrc,
                       int Ndst, int mode, char* smem, int rank, int nranks, int tbeg = 0, int tend = 1 << 30) {
  const int tidq = opaque_tid();
  float* tile = (float*)smem;
  const int tid = tidq;
  const int kt_n = K >> 8;
  const int ntiles = (Ndst >> 6) * kt_n;
  for (int t = tbeg + rank; t < ntiles && t < tend; t += nranks) {
    const int n0 = (t / kt_n) << 6, k0 = (t % kt_n) << 8;
    {
      const int i = tid & 63, j0 = tid >> 6;
      const int sc = colmap(mode, n0 + i);
      float v[32];
#pragma unroll
      for (int jj = 0; jj < 32; ++jj) v[jj] = sc >= 0 ? __builtin_nontemporal_load(src + (size_t)(k0 + j0 * 32 + jj) * Nsrc + sc) : 0.f;
#pragma unroll
      for (int jj = 0; jj < 32; ++jj) tile[(j0 * 32 + jj) * 65 + i] = v[jj];
    }
    __syncthreads();
    {
      const int kk = (tid & 127) * 2, r0 = tid >> 7;
      float ks0 = 1.f, ks1 = 1.f;
      if (kscale) { ks0 = kscale[k0 + kk]; ks1 = kscale[k0 + kk + 1]; }
#pragma unroll
      for (int rr = 0; rr < 16; ++rr) {
        const int r = r0 * 16 + rr;
        *(unsigned*)(dst + (size_t)(n0 + r) * K + k0 + kk) = pack2(tile[kk * 65 + r] * ks0, tile[(kk + 1) * 65 + r] * ks1);
      }
    }
    __syncthreads();
  }
}

namespace pg8 {
#define PG8_LAS __attribute__((address_space(3)))
typedef unsigned short bf16_t;
typedef short bf16x8 __attribute__((ext_vector_type(8)));
typedef float f32x4 __attribute__((ext_vector_type(4)));
typedef unsigned u32x4 __attribute__((ext_vector_type(4)));
constexpr int BM = 256, BK = 64, HALF = 128, HTB = HALF * BK * 2  , STAGE_BYTES = 8 * HTB, NXCD = 8, WGM = 2;

__host__ __device__ __forceinline__ int lds_byte(int r, int c) { const int st = (r >> 4) * 2 + (c >> 5), rr = r & 15, cc = c & 31, ob = rr * 64 + cc * 2; return st * 1024 + (ob ^ (((ob >> 9) & 1) << 5)); }
__host__ __device__ __forceinline__ void stage_rc(int b, int& R, int& C) { const int st = b / 1024, sb = b % 1024, swz = sb ^ (((sb >> 9) & 1) << 5); R = (st >> 1) * 16 + swz / 64; C = (st & 1) * 32 + (swz % 64) / 2; }
__host__ __device__ __forceinline__ int perm32(int rho) { const int n = rho >> 4, i = rho & 15; return 8 * (i >> 2) + 4 * n + (i & 3); }
struct Unit { int pm, pn, pk; };
struct Gemm { const bf16_t* A; const bf16_t* Bt; int M, N, K, Kloop; };
struct StaticOrder {
    int nM, nN, nwg, G, c;
    __host__ __device__ void init(int M, int N, int G_, int c_) { nM = M / BM; nN = N / BM; nwg = nM * nN; G = G_; c = c_; }
    __host__ __device__ bool next(int i, Unit& u) const {
        const long L = (long)i * G + c; if (L >= nwg) return false;
        int wgid = (int)L; { const int q = nwg / NXCD, r = nwg % NXCD, xcd = wgid % NXCD, off = wgid / NXCD; wgid = (xcd < r ? xcd * (q + 1) : r * (q + 1) + (xcd - r) * q) + off; }
        const int nig = WGM * nN, gid = wgid / nig, fm = gid * WGM, gsz = (nM - fm) < WGM ? (nM - fm) : WGM;
        u.pm = fm + ((wgid % nig) % gsz); u.pn = (wgid % nig) / gsz; u.pk = 0; return true;
    }
    __device__ __forceinline__ void a_ready(const Unit&) const {}
    __device__ __forceinline__ void done(const Unit&) const {}
};


template <int NP> DI float row_rs(const float* __restrict__ ssp, int row) {
  if (NP == 0) return ssp[row];
  float s = 0.f;
  if (NP == 1) s = ssp[row];
  else {
#pragma unroll
    for (int i = 0; i < NP / 4; ++i) { const f32x4 v = *(const f32x4*)(ssp + (size_t)row * NP + 4 * i); s += v[0] + v[1] + v[2] + v[3]; }
  }
  return rsqrtf(s * (1.f / DM) + EPS);
}

template <int NP> struct EpiSwiglu {
  static constexpr bool PERM = true, AFTER_DRAIN = false;
  bf16_t* ACT; const float* ssp;
  struct Pre { int buf; };
  DI Pre prefetch(const Unit& u, int ui, PG8_LAS unsigned char* lds, int wid, int lane) const {
    if (wid == 0) {
#pragma unroll
      for (int i = 0; i < 4; ++i) {
        int row = u.pm * BM + i * 64 + lane; row = row < MTOT ? row : MTOT - 1;
        __builtin_amdgcn_global_load_lds((const unsigned*)(ssp + row), (PG8_LAS unsigned*)(lds + RS_LDS_OFF + (ui & 1) * 1024 + i * 256), 4, 0, 0);
      }
    }
    return Pre{ui & 1};
  }
  DI void operator()(const f32x4 (&acc)[2][2][4][2], const Unit& u, int wr, int wc, int fr, int fq, const Pre& pre, PG8_LAS unsigned char* lds) const {
    const PG8_LAS float* rsl = (const PG8_LAS float*)(lds + RS_LDS_OFF + pre.buf * 1024);
    const int col = u.pn * 128 + wc * 32 + fq * 8;
#pragma unroll
    for (int ai = 0; ai < 2; ++ai)
#pragma unroll
      for (int m = 0; m < 4; ++m) {
        const int row = u.pm * BM + ai * HALF + wr * 64 + m * 16 + fr;
        if (row < MTOT) {
          const float rsin = rsl[ai * HALF + wr * 64 + m * 16 + fr];
          const float rs = NP == 0 ? rsin : rsqrtf(rsin * (1.f / DM) + EPS);
          const f32x4 g0 = acc[ai][0][m][0] * rs, g1 = acc[ai][0][m][1] * rs, u0 = acc[ai][1][m][0] * rs, u1 = acc[ai][1][m][1] * rs;
          uint4 o;
          o.x = pack2(siluf_(g0[0]) * u0[0], siluf_(g0[1]) * u0[1]);
          o.y = pack2(siluf_(g0[2]) * u0[2], siluf_(g0[3]) * u0[3]);
          o.z = pack2(siluf_(g1[0]) * u1[0], siluf_(g1[1]) * u1[1]);
          o.w = pack2(siluf_(g1[2]) * u1[2], siluf_(g1[3]) * u1[3]);
          *(uint4*)(ACT + (size_t)row * DFF + col) = o;
        }
      }
  }
};

struct EpiDown {
  static constexpr bool PERM = false, AFTER_DRAIN = false;
  const float *x_prompt, *x_sample, *meta; float* H; int resid_from_x; float scale; bf16_t* HB; float* sspo;
  struct Pre {};
  DI Pre prefetch(const Unit&, int, PG8_LAS unsigned char*, int, int) const { return Pre{}; }
  DI void operator()(const f32x4 (&acc)[2][2][4][2], const Unit& u, int wr, int wc, int fr, int fq, const Pre&, PG8_LAS unsigned char*) const {
#pragma unroll
    for (int ai = 0; ai < 2; ++ai)
#pragma unroll
      for (int m = 0; m < 4; ++m) {
        const int row = u.pm * BM + ai * HALF + wr * 64 + m * 16 + fr;
        const bool ok = row < MTOT;
        float part = 0.f;
        if (ok) {
          float* hrow = H + (size_t)row * DM;
          const float* res = resid_from_x ? xrow_ptr(x_prompt, x_sample, meta, row) : hrow;
#pragma unroll
          for (int bj = 0; bj < 2; ++bj)
#pragma unroll
            for (int n = 0; n < 2; ++n) {
              const int col = u.pn * BM + bj * HALF + wc * 32 + n * 16 + fq * 4;
              const f32x4 r = *(const f32x4*)(res + col);
              const f32x4 h = r + acc[ai][bj][m][n] * scale;
              *(f32x4*)(hrow + col) = h;
              if (HB) { uint2 o; o.x = pack2(h[0], h[1]); o.y = pack2(h[2], h[3]); *(uint2*)(HB + (size_t)row * DM + col) = o; }
              part += h[0] * h[0] + h[1] * h[1] + h[2] * h[2] + h[3] * h[3];
            }
        }
        part += __shfl_xor(part, 16);
        part += __shfl_xor(part, 32);
        if (ok && fq == 0) sspo[(size_t)row * 16 + u.pn * 4 + wc] = part;
      }
  }
};

struct EpiInproj {
  static constexpr bool PERM = true, AFTER_DRAIN = false;
  const float* ssp; float* out; char* ws; const float* dt_bias;
#define EPI_WS(name) ((bf16_t*)(ws + O_##name))
  DI static void st8(bf16_t* dst, const f32x4& a, const f32x4& b) {
    uint4 o; o.x = pack2(a[0], a[1]); o.y = pack2(a[2], a[3]); o.z = pack2(b[0], b[1]); o.w = pack2(b[2], b[3]);
    *(uint4*)dst = o;
  }
  struct Pre { int buf; };
  DI Pre prefetch(const Unit& u, int ui, PG8_LAS unsigned char* lds, int wid, int lane) const {
    if (wid == 0) {
#pragma unroll
      for (int i = 0; i < 4; ++i) {
        int row = u.pm * BM + i * 64 + lane; row = row < MTOT ? row : MTOT - 1;
        __builtin_amdgcn_global_load_lds((const unsigned*)(ssp + row), (PG8_LAS unsigned*)(lds + RS_LDS_OFF + (ui & 1) * 1024 + i * 256), 4, 0, 0);
      }
    }
    return Pre{ui & 1};
  }
  DI void operator()(const f32x4 (&acc)[2][2][4][2], const Unit& u, int wr, int wc, int fr, int fq, const Pre& pre, PG8_LAS unsigned char* lds) const {
    const PG8_LAS float* rsl = (const PG8_LAS float*)(lds + RS_LDS_OFF + pre.buf * 1024);
    const int pn = u.pn;
    const int cw = wc * 32 + fq * 8;
#pragma unroll
    for (int ai = 0; ai < 2; ++ai)
#pragma unroll
      for (int m = 0; m < 4; ++m) {
        const int row = u.pm * BM + ai * HALF + wr * 64 + m * 16 + fr;
        if (row >= MTOT) continue;
        const float rs = rsl[ai * HALF + wr * 64 + m * 16 + fr];
        int b, tt;
        const bool samp = row >= MP;
        if (!samp) { b = row / LP; tt = row - b * LP; } else { b = (row - MP) >> 2; tt = (row - MP) & 3; }
        if (pn < 8) {
          const f32x4 v0 = (acc[ai][0][m][0] * rs) * (acc[ai][1][m][0] * rs), v1 = (acc[ai][0][m][1] * rs) * (acc[ai][1][m][1] * rs);
          const int col = pn * 128 + cw;
          st8(EPI_WS(CH) + (size_t)row * DM + col, v0, v1);
          const int idx = samp ? tt - 2 : tt - (LP - 2);
          if (idx >= 0) {
            float* so = out + (samp ? OFF_SCA : OFF_PCA) + ((size_t)b * 2 + idx) * 1024 + col;
            *(f32x4*)so = v0; *(f32x4*)(so + 4) = v1;
          }
        } else if (pn < 12) {
#pragma unroll
          for (int bj = 0; bj < 2; ++bj)
            st8(EPI_WS(AB) + (size_t)row * DM + (pn - 8) * 256 + bj * 128 + cw, acc[ai][bj][m][0] * rs, acc[ai][bj][m][1] * rs);
        } else if (pn < 20) {
#pragma unroll
          for (int bj = 0; bj < 2; ++bj)
            st8(EPI_WS(R0) + (size_t)row * DSSM + (pn - 12) * 256 + bj * 128 + cw, acc[ai][bj][m][0] * rs, acc[ai][bj][m][1] * rs);
        } else if (pn < 32) {
          const int idx = samp ? tt - 1 : tt - (LP - 3);
#pragma unroll
          for (int bj = 0; bj < 2; ++bj) {
            const int col = (pn - 20) * 256 + bj * 128 + cw;
            const f32x4 v0 = acc[ai][bj][m][0] * rs, v1 = acc[ai][bj][m][1] * rs;
            st8(EPI_WS(XBC) + (size_t)row * DXBC + col, v0, v1);
            if (!samp && (tt & 63) >= 13 && (tt & 63) <= 15)
              st8(EPI_WS(HALO) + ((size_t)(b * 34 + (tt >> 6) + 1) * 3 + ((tt & 63) - 13)) * DXBC + col, v0, v1);
            if (idx >= 0) {
              float* so = out + (samp ? OFF_SSC : OFF_PSC) + ((size_t)b * 3 + idx) * DXBC + col;
              *(f32x4*)so = v0; *(f32x4*)(so + 4) = v1;
            }
          }
        } else if (pn < 40) {
          bf16_t* SG = pn < 36 ? EPI_WS(SGA) : EPI_WS(SGB);
          const int pb = pn < 36 ? 32 : 36;
#pragma unroll
          for (int bj = 0; bj < 2; ++bj) {
            f32x4 v0 = acc[ai][bj][m][0] * rs, v1 = acc[ai][bj][m][1] * rs;
#pragma unroll
            for (int j = 0; j < 4; ++j) { v0[j] = sigmoidf_(v0[j]); v1[j] = sigmoidf_(v1[j]); }
            st8(SG + (size_t)row * DM + (pn - pb) * 256 + bj * 128 + cw, v0, v1);
          }
        } else {
          if (wc == 0) {
            f32x4 v0 = acc[ai][0][m][0] * rs, v1 = acc[ai][0][m][1] * rs;
            const f32x4 b0 = *(const f32x4*)(dt_bias + fq * 8), b1 = *(const f32x4*)(dt_bias + fq * 8 + 4);
#pragma unroll
            for (int j = 0; j < 4; ++j) {
              float a = v0[j] + b0[j]; v0[j] = a > 20.f ? a : log1pf(__expf(a));
              float c = v1[j] + b1[j]; v1[j] = c > 20.f ? c : log1pf(__expf(c));
            }
            *(f32x4*)((float*)(ws + O_DT) + (size_t)row * 32 + fq * 8) = v0;
            *(f32x4*)((float*)(ws + O_DT) + (size_t)row * 32 + fq * 8 + 4) = v1;
          }
        }
      }
  }
};

template <bool ADD> struct EpiGate {
  static constexpr bool PERM = true, AFTER_DRAIN = false;
  bf16_t* O; const bf16_t* G;
  struct Pre {};
  DI Pre prefetch(const Unit&, int, PG8_LAS unsigned char*, int, int) const { return Pre{}; }
  DI void operator()(const f32x4 (&acc)[2][2][4][2], const Unit& u, int wr, int wc, int fr, int fq, const Pre&, PG8_LAS unsigned char*) const {
#pragma unroll
    for (int ai = 0; ai < 2; ++ai)
#pragma unroll
      for (int m = 0; m < 4; ++m) {
        const int row = u.pm * BM + ai * HALF + wr * 64 + m * 16 + fr;
        if (row >= MTOT) continue;
#pragma unroll
        for (int bj = 0; bj < 2; ++bj) {
          const size_t off = (size_t)row * DM + u.pn * BM + bj * HALF + wc * 32 + fq * 8;
          const uint4 g = *(const uint4*)(G + off);
          const f32x4 a0 = acc[ai][bj][m][0], a1 = acc[ai][bj][m][1];
          float v[8] = {a0[0] * bflo(g.x), a0[1] * bfhi(g.x), a0[2] * bflo(g.y), a0[3] * bfhi(g.y),
                        a1[0] * bflo(g.z), a1[1] * bfhi(g.z), a1[2] * bflo(g.w), a1[3] * bfhi(g.w)};
          if (ADD) {
            const uint4 o = *(const uint4*)(O + off);
            v[0] += bflo(o.x); v[1] += bfhi(o.x); v[2] += bflo(o.y); v[3] += bfhi(o.y);
            v[4] += bflo(o.z); v[5] += bfhi(o.z); v[6] += bflo(o.w); v[7] += bfhi(o.w);
          }
          uint4 r; r.x = pack2(v[0], v[1]); r.y = pack2(v[2], v[3]); r.z = pack2(v[4], v[5]); r.w = pack2(v[6], v[7]);
          *(uint4*)(O + off) = r;
        }
      }
  }
};

template <class Epi, class Sched, bool STAMP = false>
__device__ __forceinline__ void gemm_phase(PG8_LAS unsigned char* lds, const Gemm g, const Sched& S, const Epi& E, unsigned long long* stamps) {
    const int tid = opaque_tid(), wid = __builtin_amdgcn_readfirstlane(tid >> 6), lane = tid & 63, wr = wid >> 2, wc = wid & 3, fr = lane & 15, fq = lane >> 4;
    const int K = g.K, nt = g.Kloop / BK;
    int ts_lo = 0, ts_hi = 0, nts = 0; const unsigned long long rt_entry = STAMP ? (unsigned long long)wall_clock64() : 0ull;
#define PG8_STAMP() do { if (STAMP && wid == 0 && nts < 64) { const unsigned long long _c = (unsigned long long)clock64(); \
        ts_lo = (lane == nts) ? (int)(unsigned)_c : ts_lo; ts_hi = (lane == nts) ? (int)(unsigned)(_c >> 32) : ts_hi; ++nts; } } while (0)
    PG8_STAMP();
    unsigned voffA[2], voffB[2];
#pragma unroll
    for (int i = 0; i < 2; ++i) { int R, C; stage_rc(tid * 16 + i * 8192, R, C); const int Rb = Epi::PERM ? ((R & ~31) + perm32(R & 31)) : R;
        voffA[i] = (unsigned)(R * K + C) * 2u; voffB[i] = (unsigned)(Rb * K + C) * 2u; }
    const size_t kstep = (size_t)(BK * 2);
    const size_t hstep = (size_t)HALF * K * 2;
    const size_t tstep = 2 * hstep;
    const unsigned ldsw = (unsigned)wid * 1024u;
    const int aoff = lds_byte(wr * 64 + fr, fq * 8), boff = lds_byte(wc * 32 + fr, fq * 8);
#define PG8_SA(b, h) (((b) * 2 + (h)) * HTB)
#define PG8_SB(b, h) ((4 + (b) * 2 + (h)) * HTB)
#define PG8_STAGE(bufoff, gbase, voff) do { _Pragma("unroll") for (int _i = 0; _i < 2; ++_i) \
        __builtin_amdgcn_global_load_lds((const unsigned*)((const char*)(gbase) + (voff)[_i]), (PG8_LAS unsigned*)(lds + (bufoff) + ldsw + _i * 8192), 16, 0, 0); } while (0)
#define PG8_LDA(dst, b, h) do { _Pragma("unroll") for (int m = 0; m < 4; ++m) _Pragma("unroll") for (int k = 0; k < 2; ++k) dst[m][k] = *(const PG8_LAS bf16x8*)(lds + PG8_SA(b, h) + aoff + m * 2048 + k * 1024); } while (0)
#define PG8_LDB(dst, b, h) do { _Pragma("unroll") for (int n = 0; n < 2; ++n) _Pragma("unroll") for (int k = 0; k < 2; ++k) dst[n][k] = *(const PG8_LAS bf16x8*)(lds + PG8_SB(b, h) + boff + n * 2048 + k * 1024); } while (0)
#define PG8_MMA(ai, bj, At, Bt) do { __builtin_amdgcn_s_setprio(1); _Pragma("unroll") for (int m = 0; m < 4; ++m) _Pragma("unroll") for (int n = 0; n < 2; ++n) _Pragma("unroll") for (int k = 0; k < 2; ++k) \
        acc[ai][bj][m][n] = __builtin_amdgcn_mfma_f32_16x16x32_bf16(Bt[n][k], At[m][k], acc[ai][bj][m][n], 0, 0, 0); __builtin_amdgcn_s_setprio(0); } while (0)
#define PG8_WAIT_V(n) asm volatile("s_waitcnt vmcnt(" #n ")" ::: "memory")
#define PG8_WAIT_L(n) asm volatile("s_waitcnt lgkmcnt(" #n ")" ::: "memory")
#define PG8_BAR __builtin_amdgcn_s_barrier()
#define PG8_SCHED __builtin_amdgcn_sched_barrier(0)
    Unit cur, nxt; int ui = 0;
    if (!S.next(0, cur)) return;
    f32x4 acc[2][2][4][2];
#pragma unroll
    for (int a = 0; a < 2; ++a)
#pragma unroll
        for (int b = 0; b < 2; ++b)
#pragma unroll
            for (int m = 0; m < 4; ++m)
#pragma unroll
                for (int n = 0; n < 2; ++n) acc[a][b][m][n] = (f32x4){0.f, 0.f, 0.f, 0.f};
    bf16x8 At[4][2], B0[2][2], B1[2][2];
    const char* cA = (const char*)g.A + (size_t)cur.pm * tstep + (size_t)cur.pk * g.Kloop * 2; const char* cB = (const char*)g.Bt + (size_t)cur.pn * tstep + (size_t)cur.pk * g.Kloop * 2;
    S.a_ready(cur);
    PG8_STAGE(PG8_SB(0, 0), cB, voffB); PG8_STAGE(PG8_SA(0, 0), cA, voffA); PG8_STAGE(PG8_SB(0, 1), cB + hstep, voffB); PG8_STAGE(PG8_SA(0, 1), cA + hstep, voffA);
    if (wr == 1) PG8_BAR;
    PG8_WAIT_V(4); PG8_BAR;
    PG8_STAGE(PG8_SB(1, 0), cB + kstep, voffB); PG8_STAGE(PG8_SA(1, 0), cA + kstep, voffA); PG8_STAGE(PG8_SB(1, 1), cB + hstep + kstep, voffB);
    PG8_WAIT_V(6); PG8_BAR;
    PG8_STAMP();
    for (;;) {
        const bool has_next = S.next(ui + 1, nxt);
        const char* nA = has_next ? (const char*)g.A + (size_t)nxt.pm * tstep + (size_t)nxt.pk * g.Kloop * 2 : cA; const char* nB = has_next ? (const char*)g.Bt + (size_t)nxt.pn * tstep + (size_t)nxt.pk * g.Kloop * 2 : cB;
        const typename Epi::Pre pre = E.prefetch(cur, ui, lds, wid, lane);
        for (int t = 0; t < nt; t += 2) {
            const bool last = (t == nt - 2);
            const char* a1 = cA + (size_t)(t + 1) * kstep;
            const char* a2 = last ? nA : cA + (size_t)(t + 2) * kstep; const char* b2 = last ? nB : cB + (size_t)(t + 2) * kstep;
            const char* a3 = a2 + kstep; const char* b3 = b2 + kstep;
            if (last && has_next) S.a_ready(nxt);
            PG8_LDB(B0, 0, 0); PG8_SCHED; PG8_LDA(At, 0, 0); PG8_STAGE(PG8_SA(1, 1), a1 + hstep, voffA);
            PG8_WAIT_L(8); PG8_BAR; PG8_WAIT_L(0); PG8_MMA(0, 0, At, B0); PG8_BAR; PG8_SCHED;
            PG8_LDB(B1, 0, 1); PG8_STAGE(PG8_SB(0, 0), b2, voffB);
            PG8_BAR; PG8_WAIT_L(0); PG8_MMA(0, 1, At, B1); PG8_BAR;
            PG8_LDA(At, 0, 1); PG8_STAGE(PG8_SA(0, 0), a2, voffA);
            PG8_BAR; PG8_WAIT_L(0); PG8_MMA(1, 0, At, B0); PG8_BAR; PG8_SCHED;
            PG8_STAGE(PG8_SB(0, 1), b2 + hstep, voffB);
            PG8_WAIT_V(6); PG8_BAR; PG8_MMA(1, 1, At, B1); PG8_BAR;
            PG8_LDB(B0, 1, 0); PG8_SCHED; PG8_LDA(At, 1, 0); PG8_STAGE(PG8_SA(0, 1), a2 + hstep, voffA);
            PG8_WAIT_L(8); PG8_BAR; PG8_WAIT_L(0); PG8_MMA(0, 0, At, B0); PG8_BAR; PG8_SCHED;
            PG8_LDB(B1, 1, 1); PG8_STAGE(PG8_SB(1, 0), b3, voffB);
            PG8_BAR; PG8_WAIT_L(0); PG8_MMA(0, 1, At, B1); PG8_BAR;
            PG8_LDA(At, 1, 1); PG8_STAGE(PG8_SA(1, 0), a3, voffA);
            PG8_BAR; PG8_WAIT_L(0); PG8_MMA(1, 0, At, B0); PG8_BAR; PG8_SCHED;
            PG8_STAGE(PG8_SB(1, 1), b3 + hstep, voffB);
            PG8_WAIT_V(6); PG8_BAR; PG8_MMA(1, 1, At, B1); PG8_BAR;
        }
        PG8_STAMP();
        if constexpr (!Epi::AFTER_DRAIN) { E(acc, cur, wr, wc, fr, fq, pre, lds); S.done(cur); }
        PG8_STAMP();
        if (!has_next) break;
#pragma unroll
        for (int a = 0; a < 2; ++a)
#pragma unroll
            for (int b = 0; b < 2; ++b)
#pragma unroll
                for (int m = 0; m < 4; ++m)
#pragma unroll
                    for (int n = 0; n < 2; ++n) acc[a][b][m][n] = (f32x4){0.f, 0.f, 0.f, 0.f};
        cur = nxt; cA = nA; cB = nB; ++ui;
    }
    PG8_WAIT_V(0);
    if (wr == 0) PG8_BAR;
    PG8_BAR;
    if constexpr (Epi::AFTER_DRAIN) { E.fused(acc, cur, wr, wc, fr, fq, lds, wid, lane); S.done(cur); }
    PG8_STAMP();
    if (STAMP && wid == 0) { stamps[lane] = lane < nts ? (((unsigned long long)(unsigned)ts_hi << 32) | (unsigned)ts_lo) : 0ull;
        if (lane == 62) stamps[62] = rt_entry; if (lane == 63) stamps[63] = (unsigned long long)wall_clock64(); }
#undef PG8_STAMP
#undef PG8_SA
#undef PG8_SB
#undef PG8_STAGE
#undef PG8_LDA
#undef PG8_LDB
#undef PG8_MMA
#undef PG8_WAIT_V
#undef PG8_WAIT_L
#undef PG8_BAR
#undef PG8_SCHED
}
}


namespace pg8 {
struct PanelOrder {
  int c;
  __device__ __forceinline__ bool next(int i, Unit& u) const { if (i > 0) return false; const int x = c & 7, r = c >> 3; u.pm = 8 * x + (r & 7); u.pn = r >> 3; u.pk = 0; return true; }
  __device__ __forceinline__ void a_ready(const Unit&) const {}
  __device__ __forceinline__ void done(const Unit&) const {}
};
struct TailOrder {
  int c, S, c0;
  __device__ __forceinline__ bool next(int i, Unit& u) const { const int cc = c - c0; if (i > 0 || cc < 0 || cc >= 12 * S) return false; const int t = cc / S; u.pm = 64 + (t >> 2); u.pn = t & 3; u.pk = cc - t * S; return true; }
  __device__ __forceinline__ void a_ready(const Unit&) const {}
  __device__ __forceinline__ void done(const Unit&) const {}
};
struct EpiSlab {
  static constexpr bool PERM = false, AFTER_DRAIN = false;
  float* slab;
  struct Pre {};
  DI Pre prefetch(const Unit&, int, PG8_LAS unsigned char*, int, int) const { return Pre{}; }
  DI void operator()(const f32x4 (&acc)[2][2][4][2], const Unit& u, int wr, int wc, int fr, int fq, const Pre&, PG8_LAS unsigned char*) const {
#pragma unroll
    for (int ai = 0; ai < 2; ++ai)
#pragma unroll
      for (int m = 0; m < 4; ++m) {
        const int lr = (u.pm - 64) * BM + ai * HALF + wr * 64 + m * 16 + fr;
        float* rowp = slab + ((size_t)u.pk * 768 + lr) * DM;
#pragma unroll
        for (int bj = 0; bj < 2; ++bj)
#pragma unroll
          for (int n = 0; n < 2; ++n) *(f32x4*)(rowp + u.pn * BM + bj * HALF + wc * 32 + n * 16 + fq * 4) = acc[ai][bj][m][n];
      }
  }
};
}
DI int unit_c(const char* smem) { return __builtin_amdgcn_readfirstlane(*(const int*)(smem + SITEM_OFF + 36)); }
template <class Epi> DI void run_gemm_panel(char* smem, const bf16_t* A, const bf16_t* Bt, int N, int K, const Epi& E) {
  pg8::PanelOrder S{unit_c(smem)};
  pg8::Gemm g{A, Bt, MPAD, N, K, K};
  pg8::gemm_phase<Epi, pg8::PanelOrder, false>((PG8_LAS unsigned char*)smem, g, S, E, nullptr);
}
DI void run_gemm_tail(char* smem, const bf16_t* A, const bf16_t* Bt, int N, int K, int nsplit, float* slab, int c0 = 0) {
  pg8::TailOrder S{unit_c(smem), nsplit, c0};
  pg8::Gemm g{A, Bt, MPAD, N, K, K / nsplit};
  pg8::EpiSlab E{slab};
  pg8::gemm_phase<pg8::EpiSlab, pg8::TailOrder, false>((PG8_LAS unsigned char*)smem, g, S, E, nullptr);
}
constexpr int TAIL_ROW0 = 16384;
template <int NS> DI void fixup_down(const Params& p, bool resid_from_x, float scale, bf16_t* HB) {
  const int tidq = opaque_tid();
  const int lane = tidq & 63, wid = tidq >> 6;
  const float* slab = (const float*)WSB(p, XBC);
  for (int row = TAIL_ROW0 + blockIdx.x * 8 + wid; row < MTOT; row += gridDim.x * 8) {
    float* hrow = WSF(p, H) + (size_t)row * DM;
    const float* res = resid_from_x ? xrow_ptr(p.x_prompt, p.x_sample, p.meta, row) : hrow;
    float ss = 0.f;
#pragma unroll
    for (int i = 0; i < 4; ++i) {
      const int col = i * 256 + lane * 4;
      f32x4 a = {0.f, 0.f, 0.f, 0.f};
      f32x4 pv[NS];
#pragma unroll
      for (int k = 0; k < NS; ++k) pv[k] = *(const f32x4*)(slab + ((size_t)k * 768 + (row - TAIL_ROW0)) * DM + col);
#pragma unroll
      for (int k = 0; k < NS; ++k) a += pv[k];
      const f32x4 h = *(const f32x4*)(res + col) + a * scale;
      *(f32x4*)(hrow + col) = h;
      if (HB) { uint2 o; o.x = pack2(h[0], h[1]); o.y = pack2(h[2], h[3]); *(uint2*)(HB + (size_t)row * DM + col) = o; }
      ss += h[0] * h[0] + h[1] * h[1] + h[2] * h[2] + h[3] * h[3];
    }
#pragma unroll
    for (int d = 1; d < 64; d <<= 1) ss += __shfl_xor(ss, d);
    if (lane < 16) WSF(p, ssp)[(size_t)row * 16 + lane] = lane == 0 ? ss : 0.f;
    if (lane == 0) WSF(p, rsv)[row] = rsqrtf(ss * (1.f / DM) + EPS);
  }
  for (int row = blockIdx.x * NTHREADS + tidq; row < TAIL_ROW0; row += gridDim.x * NTHREADS) {
    const float* sp = WSF(p, ssp) + (size_t)row * 16;
    const f32x4 a = *(const f32x4*)sp, b = *(const f32x4*)(sp + 4), c = *(const f32x4*)(sp + 8), d = *(const f32x4*)(sp + 12);
    const float ss = (a[0] + a[1] + a[2] + a[3]) + (b[0] + b[1] + b[2] + b[3]) + (c[0] + c[1] + c[2] + c[3]) + (d[0] + d[1] + d[2] + d[3]);
    WSF(p, rsv)[row] = rsqrtf(ss * (1.f / DM) + EPS);
  }
}

DI void fixup_merge(const Params& p) {
  const int tidq = opaque_tid();
  const float* slab = (const float*)WSB(p, XBC);
  const int gt = blockIdx.x * NTHREADS + tidq, gn = gridDim.x * NTHREADS;
  for (int idx = gt; idx < (MTOT - TAIL_ROW0) * 256; idx += gn) {
    const int lr = idx >> 8, col = (idx & 255) * 4;
    f32x4 a = {0.f, 0.f, 0.f, 0.f}, b = {0.f, 0.f, 0.f, 0.f};
#pragma unroll
    for (int k = 0; k < 4; ++k) a += *(const f32x4*)(slab + ((size_t)k * 768 + lr) * DM + col);
#pragma unroll
    for (int k = 0; k < 8; ++k) b += *(const f32x4*)(slab + ((size_t)(4 + k) * 768 + lr) * DM + col);
    const size_t off = (size_t)(TAIL_ROW0 + lr) * DM + col;
    const uint2 ga = *(const uint2*)(WSB(p, SGA) + off), gb = *(const uint2*)(WSB(p, SGB) + off);
    uint2 o;
    o.x = pack2(a[0] * bflo(ga.x) + b[0] * bflo(gb.x), a[1] * bfhi(ga.x) + b[1] * bfhi(gb.x));
    o.y = pack2(a[2] * bflo(ga.y) + b[2] * bflo(gb.y), a[3] * bfhi(ga.y) + b[3] * bfhi(gb.y));
    *(uint2*)(WSB(p, AB) + off) = o;
  }
}

template <class Epi> DI void run_gemm(char* smem, const bf16_t* A, const bf16_t* Bt, int N, int K, const Epi& E) {
  pg8::StaticOrder S;
  S.init(MPAD, N, (int)gridDim.x, __builtin_amdgcn_readfirstlane(*(const int*)(smem + SITEM_OFF + 36)));
  pg8::Gemm g{A, Bt, MPAD, N, K, K};
  pg8::gemm_phase<Epi, pg8::StaticOrder, false>((PG8_LAS unsigned char*)smem, g, S, E, nullptr);
}

constexpr int SC_OFF = 0, SB_OFF = 17408, SXT_OFF = 34816, SH_OFF = 44032, SG_OFF = 61440, SDT_OFF = 70656, SACS_OFF = 70912,
              SWT_OFF = 71168;
constexpr int LDN = 136;
constexpr int LDQ = 72;

DI void unpack8(const uint4& u, float (&v)[8]) {
  v[0] = bflo(u.x); v[1] = bfhi(u.x); v[2] = bflo(u.y); v[3] = bfhi(u.y);
  v[4] = bflo(u.z); v[5] = bfhi(u.z); v[6] = bflo(u.w); v[7] = bfhi(u.w);
}

DI void phase_conv(const Params& p) {
  const int tidq = opaque_tid();
  const int gt = blockIdx.x * NTHREADS + tidq, gn = gridDim.x * NTHREADS;
  constexpr int NPI = 8 * 33 * 384, NSI = 128 * 384;
  bf16_t* XBC = WSB(p, XBC);
  const bf16_t* HALO = WSB(p, HALO);
  for (int idx = gt; idx < NPI + NSI; idx += gn) {
    int ch, t0, t1, rowbase;
    float x0[8], x1[8], x2[8];
    if (idx < NPI) {
      const int ch8 = idx % 384, r = idx / 384, c = r % 33, b = r / 33;
      ch = ch8 * 8;
      t0 = c == 0 ? 0 : 64 * c - 48; t1 = 64 * c + 16; rowbase = b * LP;
      if (c == 0) {
#pragma unroll
        for (int e = 0; e < 8; ++e) { x0[e] = 0.f; x1[e] = 0.f; x2[e] = 0.f; }
      } else {
        const bf16_t* hp = HALO + (size_t)(b * 34 + c) * 3 * DXBC + ch;
        unpack8(*(const uint4*)hp, x0); unpack8(*(const uint4*)(hp + DXBC), x1); unpack8(*(const uint4*)(hp + 2 * DXBC), x2);
      }
    } else {
      const int i2 = idx - NPI, ch8 = i2 % 384, b = i2 / 384;
      ch = ch8 * 8;
      t0 = 0; t1 = 4; rowbase = MP + b * 4;
      const float* hp = p.st_ssm_conv + (size_t)b * 3 * DXBC + ch;
#pragma unroll
      for (int e = 0; e < 8; ++e) { x0[e] = hp[e]; x1[e] = hp[DXBC + e]; x2[e] = hp[2 * DXBC + e]; }
    }
    float w0[8], w1[8], w2[8], w3[8], bs[8];
#pragma unroll
    for (int e = 0; e < 8; ++e) {
      w0[e] = p.ssm_conv_w[ch + e]; w1[e] = p.ssm_conv_w[DXBC + ch + e]; w2[e] = p.ssm_conv_w[2 * DXBC + ch + e]; w3[e] = p.ssm_conv_w[3 * DXBC + ch + e];
      bs[e] = p.ssm_conv_b[ch + e];
    }
    const int GR = (t1 - t0) >= 8 ? 8 : 4;
    for (int t = t0; t < t1; t += GR) {
      bf16_t* rp = XBC + (size_t)(rowbase + t) * DXBC + ch;
      uint4 raw[8];
#pragma unroll
      for (int k = 0; k < 8; ++k) if (k < GR) raw[k] = *(const uint4*)(rp + (size_t)k * DXBC);
#pragma unroll
      for (int k = 0; k < 8; ++k) if (k < GR) {
        float x3[8], o[8];
        unpack8(raw[k], x3);
#pragma unroll
        for (int e = 0; e < 8; ++e) {
          o[e] = siluf_(bs[e] + w0[e] * x0[e] + w1[e] * x1[e] + w2[e] * x2[e] + w3[e] * x3[e]);
          x0[e] = x1[e]; x1[e] = x2[e]; x2[e] = x3[e];
        }
        uint4 pk;
        pk.x = pack2(o[0], o[1]); pk.y = pack2(o[2], o[3]); pk.z = pack2(o[4], o[5]); pk.w = pack2(o[6], o[7]);
        *(uint4*)(rp + (size_t)k * DXBC) = pk;
      }
    }
  }
}

DI void ua_slice(const Params& p, int slice, int nslices, int tid) {
  bf16_t* UA = WSB(p, R1);
  const bf16_t* CH = WSB(p, CH);
  const bf16_t* AB = WSB(p, AB);
  const int c0 = (tid & 127) * 8;
#pragma unroll 1
  for (int rp = slice; rp < MTOT / 2; rp += nslices) {
    const int row = 2 * rp + (tid >> 7);
    int b, t;
    const bool smp = row >= MP;
    if (!smp) { b = row / LP; t = row - b * LP; } else { b = (row - MP) >> 2; t = (row - MP) & 3; }
    const uint4 ab = *(const uint4*)(AB + (size_t)row * DM + c0);
    uint4 ch[3];
#pragma unroll
    for (int k = 0; k < 3; ++k) ch[k] = *(const uint4*)(CH + (size_t)(row - ((t - 2 + k) >= 0 ? 2 - k : 0)) * DM + c0);
    float conv[8];
#pragma unroll
    for (int e = 0; e < 8; ++e) conv[e] = 0.f;
#pragma unroll
    for (int k = 0; k < 3; ++k) {
      const int tt = t - 2 + k;
      float v[8];
      if (tt >= 0) {
        unpack8(ch[k], v);
      } else if (smp) {
        const float* hp = p.st_conv_a + ((size_t)b * 2 + (tt + 2)) * DM + c0;
        const float4 a0 = *(const float4*)hp, a1 = *(const float4*)(hp + 4);
        v[0] = a0.x; v[1] = a0.y; v[2] = a0.z; v[3] = a0.w; v[4] = a1.x; v[5] = a1.y; v[6] = a1.z; v[7] = a1.w;
      } else {
#pragma unroll
        for (int e = 0; e < 8; ++e) v[e] = 0.f;
      }
      const float4 w0 = *(const float4*)(p.conv_a_w + k * DM + c0), w1 = *(const float4*)(p.conv_a_w + k * DM + c0 + 4);
      conv[0] += w0.x * v[0]; conv[1] += w0.y * v[1]; conv[2] += w0.z * v[2]; conv[3] += w0.w * v[3];
      conv[4] += w1.x * v[4]; conv[5] += w1.y * v[5]; conv[6] += w1.z * v[6]; conv[7] += w1.w * v[7];
    }
    float av[8];
    unpack8(ab, av);
    uint4 o;
    o.x = pack2(av[0] * conv[0], av[1] * conv[1]);
    o.y = pack2(av[2] * conv[2], av[3] * conv[3]);
    o.z = pack2(av[4] * conv[4], av[5] * conv[5]);
    o.w = pack2(av[6] * conv[6], av[7] * conv[7]);
    *(uint4*)(UA + (size_t)row * DM + c0) = o;
  }
}

constexpr int SAL_OFF = 71424;
DI void phase_ssd(const Params& p, char* smem_all, int dry) {
  const int half = threadIdx.x >> 8;
  char* smem = smem_all + half * SSD_HALF_BYTES;
  const int tid = opaque_tid() & 255;
  int tidx = tid, lane = tid & 63, w = tid >> 6, fr = lane & 15, fq = lane >> 4;
  bf16_t* sC = (bf16_t*)(smem + SC_OFF);
  bf16_t* sB = (bf16_t*)(smem + SB_OFF);
  bf16_t* sXT = (bf16_t*)(smem + SXT_OFF);
  bf16_t* sH = (bf16_t*)(smem + SH_OFF);
  bf16_t* sG = (bf16_t*)(smem + SG_OFF);
  float* s_dt = (float*)(smem + SDT_OFF);
  float* s_acs = (float*)(smem + SACS_OFF);
  float* s_wt = (float*)(smem + SWT_OFF);
  float* s_al = (float*)(smem + SAL_OFF);
  const bf16_t* XC = WSB(p, XBC);
  bf16_t* ZY = WSB(p, R0);
  const float* DT = WSF(p, DT);
  const bool samp = half == 1;
  const int nreal = samp ? 16 : 33;
  const int uc = unit_c(smem_all);
  const int item0 = samp ? uc * 16 : (uc & 7) * 32 + (uc >> 3);
  int cc = tid & 7, ix = tid >> 3;
  int c16 = tid & 15, ib = tid >> 4;

  if (tid < 32) { s_al[tid] = -__expf(p.a_log[tid]); s_al[32 + tid] = p.d_skip[tid]; }
  if (!samp) __builtin_amdgcn_s_setprio(3);

  uint4 rx[2], rb[4], rc[4];
  uint2 rz[4];
  float dtv = 0.f;
  f32x4 hacc[4][2], hnext[4][2];
  const uint4 zero4 = make_uint4(0u, 0u, 0u, 0u);
#define SSD_STEP(k_, h_, rowbase_, tb_, L_) do { \
    if (samp) { const int it_ = item0 + (k_); h_ = it_ & 31; rowbase_ = MP + (it_ >> 5) * 4; tb_ = 0; L_ = 4; } \
    else { h_ = item0 & 31; rowbase_ = (item0 >> 5) * LP; tb_ = (k_) * 64 - 48; L_ = LP; } } while (0)
#define SSD_PREFETCH(k_) do { \
    int h_, rowbase_, tb_, L_; SSD_STEP(k_, h_, rowbase_, tb_, L_); const int g_ = h_ >> 3; \
    _Pragma("unroll") for (int u = 0; u < 2; ++u) { \
      const int t_ = tb_ + 2 * ix + u; const bool v_ = t_ >= 0 && t_ < L_; const size_t r_ = (size_t)(rowbase_ + (v_ ? t_ : 0)); \
      rx[u] = *(const uint4*)(XC + r_ * DXBC + h_ * 64 + cc * 8); } \
    _Pragma("unroll") for (int u = 0; u < 4; ++u) { \
      const int t_ = tb_ + ib + 16 * u; const bool v_ = t_ >= 0 && t_ < L_; const size_t r_ = (size_t)(rowbase_ + (v_ ? t_ : 0)); \
      rb[u] = *(const uint4*)(XC + r_ * DXBC + 2048 + g_ * 128 + c16 * 8); rc[u] = *(const uint4*)(XC + r_ * DXBC + 2560 + g_ * 128 + c16 * 8); } \
    { const int t_ = tb_ + w * 16 + fr; const bool v_ = t_ >= 0 && t_ < L_; const size_t r_ = (size_t)(rowbase_ + (v_ ? t_ : 0)); \
      _Pragma("unroll") for (int m = 0; m < 4; ++m) rz[m] = *(const uint2*)(ZY + r_ * DSSM + h_ * 64 + m * 16 + fq * 4); } \
    if (w == 0) { const int t_ = tb_ + lane; const bool v_ = t_ >= 0 && t_ < L_; dtv = DT[(size_t)(rowbase_ + (v_ ? t_ : 0)) * 32 + h_]; } \
    if (samp) { const float* st_in = p.st_ssm + (size_t)(item0 + (k_)) * 64 * 128; \
      _Pragma("unroll") for (int m = 0; m < 4; ++m) _Pragma("unroll") for (int nn = 0; nn < 2; ++nn) _Pragma("unroll") for (int j = 0; j < 4; ++j) \
        hnext[m][nn][j] = __builtin_nontemporal_load(st_in + (m * 16 + fq * 4 + j) * 128 + w * 32 + nn * 16 + fr); } \
  } while (0)
#define SSD_FRESH() do { int t_ = tid; asm volatile("" : "+v"(t_)); tidx = t_; lane = tidx & 63; w = tidx >> 6; fr = lane & 15; fq = lane >> 4; \
                         cc = tidx & 7; ix = tidx >> 3; c16 = tidx & 15; ib = tidx >> 4; } while (0)
#pragma unroll
  for (int m = 0; m < 4; ++m)
#pragma unroll
    for (int nn = 0; nn < 2; ++nn) { hacc[m][nn] = f32x4{0.f, 0.f, 0.f, 0.f}; hnext[m][nn] = f32x4{0.f, 0.f, 0.f, 0.f}; }
  SSD_PREFETCH(0);
  __syncthreads();

  for (int c = 0; c < 33; ++c) {
    const bool active = c < nreal;
    int h = 0, rowbase = 0, tbase = 0, L = 0;
    SSD_STEP(c, h, rowbase, tbase, L);
    float a = 0.f, Dh = 0.f;
    if (active) {
      SSD_FRESH();
      a = s_al[h]; Dh = s_al[32 + h];
      if (samp) {
#pragma unroll
        for (int m = 0; m < 4; ++m)
#pragma unroll
          for (int nn = 0; nn < 2; ++nn) hacc[m][nn] = hnext[m][nn];
      }
#pragma unroll
      for (int m = 0; m < 4; ++m)
#pragma unroll
        for (int nn = 0; nn < 2; ++nn)
#pragma unroll
          for (int j = 0; j < 4; j += 2) {
            const unsigned pk = pack2(hacc[m][nn][j], hacc[m][nn][j + 1]);
            sH[(m * 16 + fq * 4 + j) * LDN + w * 32 + nn * 16 + fr] = (bf16_t)(pk & 0xffffu);
            sH[(m * 16 + fq * 4 + j + 1) * LDN + w * 32 + nn * 16 + fr] = (bf16_t)(pk >> 16);
          }
      if (w == 0) {
        { const int t_ = tbase + lane; if (!(t_ >= 0 && t_ < L)) dtv = 0.f; }
        float sc = dtv * a;
#pragma unroll
        for (int d = 1; d < 64; d <<= 1) {
          const float o = __shfl_up(sc, d);
          if (lane >= d) sc += o;
        }
        const float total = __shfl(sc, 63);
        s_dt[lane] = dtv;
        s_acs[lane] = sc;
        s_wt[lane] = dtv * __expf(total - sc);
      }
      if (!samp && c >= 1) {
        const unsigned x0[4] = {rx[0].x, rx[0].y, rx[0].z, rx[0].w}, x1[4] = {rx[1].x, rx[1].y, rx[1].z, rx[1].w};
#pragma unroll
        for (int e = 0; e < 4; ++e) {
          *(unsigned*)(sXT + (cc * 8 + 2 * e) * LDQ + 2 * ix) = (x0[e] & 0xffffu) | (x1[e] << 16);
          *(unsigned*)(sXT + (cc * 8 + 2 * e + 1) * LDQ + 2 * ix) = (x0[e] >> 16) | (x1[e] & 0xffff0000u);
        }
#pragma unroll
        for (int u = 0; u < 4; ++u) {
          const int i = ib + 16 * u;
          *(uint4*)(sB + i * LDN + c16 * 8) = rb[u];
          *(uint4*)(sC + i * LDN + c16 * 8) = rc[u];
        }
      } else {
        {
        const int t0_ = tbase + 2 * ix, t1_ = t0_ + 1;
        const unsigned m0_ = (t0_ >= 0 && t0_ < L) ? 0xffffffffu : 0u, m1_ = (t1_ >= 0 && t1_ < L) ? 0xffffffffu : 0u;
        const unsigned x0[4] = {rx[0].x & m0_, rx[0].y & m0_, rx[0].z & m0_, rx[0].w & m0_}, x1[4] = {rx[1].x & m1_, rx[1].y & m1_, rx[1].z & m1_, rx[1].w & m1_};
#pragma unroll
        for (int e = 0; e < 4; ++e) {
          *(unsigned*)(sXT + (cc * 8 + 2 * e) * LDQ + 2 * ix) = (x0[e] & 0xffffu) | (x1[e] << 16);
          *(unsigned*)(sXT + (cc * 8 + 2 * e + 1) * LDQ + 2 * ix) = (x0[e] >> 16) | (x1[e] & 0xffff0000u);
        }
      }
#pragma unroll
      for (int u = 0; u < 4; ++u) {
        const int i = ib + 16 * u;
        const int t_ = tbase + i;
        const unsigned mk_ = (t_ >= 0 && t_ < L) ? 0xffffffffu : 0u;
        *(uint4*)(sB + i * LDN + c16 * 8) = make_uint4(rb[u].x & mk_, rb[u].y & mk_, rb[u].z & mk_, rb[u].w & mk_);
        *(uint4*)(sC + i * LDN + c16 * 8) = make_uint4(rc[u].x & mk_, rc[u].y & mk_, rc[u].z & mk_, rc[u].w & mk_);
      }
      }
    }
    uint2 zc[4];
#pragma unroll
    for (int m = 0; m < 4; ++m) zc[m] = rz[m];
    if (c + 1 < nreal) SSD_PREFETCH(c + 1);
    __syncthreads();
    if (active && (!samp || w == 0)) {
      SSD_FRESH();
      f32x4 cb[4], y[4];
#pragma unroll
      for (int m = 0; m < 4; ++m) { cb[m] = f32x4{0.f, 0.f, 0.f, 0.f}; y[m] = f32x4{0.f, 0.f, 0.f, 0.f}; }
#pragma unroll
      for (int ks = 0; ks < 4; ++ks) {
        const bf16x8 cf = *(const bf16x8*)(sC + (w * 16 + fr) * LDN + ks * 32 + fq * 8);
        bf16x8 bb[4], hh[4];
#pragma unroll
        for (int m = 0; m < 4; ++m) {
          bb[m] = *(const bf16x8*)(sB + (m * 16 + fr) * LDN + ks * 32 + fq * 8);
          hh[m] = *(const bf16x8*)(sH + (m * 16 + fr) * LDN + ks * 32 + fq * 8);
        }
        __builtin_amdgcn_sched_barrier(0);
#pragma unroll
        for (int m = 0; m < 4; ++m) {
          cb[m] = MFMA16(bb[m], cf, cb[m]);
          y[m] = MFMA16(hh[m], cf, y[m]);
        }
        __builtin_amdgcn_sched_barrier(0);
      }
      {
        const int q = w * 16 + fr;
        const float aq = s_acs[q];
        const float eq = __expf(aq);
#pragma unroll
        for (int m = 0; m < 4; ++m) {
          const int s0 = m * 16 + fq * 4;
          const f32x4 as = *(const f32x4*)(s_acs + s0), ds = *(const f32x4*)(s_dt + s0);
          float v[4];
#pragma unroll
          for (int j = 0; j < 4; ++j) {
            const int sidx = s0 + j;
            float val = (sidx <= q) ? cb[m][j] * __expf(aq - as[j]) * ds[j] : 0.f;
            if (sidx == q) val += Dh;
            v[j] = val;
          }
          uint2 pk; pk.x = pack2(v[0], v[1]); pk.y = pack2(v[2], v[3]);
          *(uint2*)(sG + q * LDQ + s0) = pk;
          y[m] *= eq;
        }
      }
      SSD_FRESH();
      {
        bf16x8 gf[2], xf[2][4];
#pragma unroll
        for (int ks = 0; ks < 2; ++ks) {
          gf[ks] = *(const bf16x8*)(sG + (w * 16 + fr) * LDQ + ks * 32 + fq * 8);
#pragma unroll
          for (int m = 0; m < 4; ++m) xf[ks][m] = *(const bf16x8*)(sXT + (m * 16 + fr) * LDQ + ks * 32 + fq * 8);
        }
        __builtin_amdgcn_sched_barrier(0);
#pragma unroll
        for (int ks = 0; ks < 2; ++ks)
#pragma unroll
          for (int m = 0; m < 4; ++m) y[m] = MFMA16(xf[ks][m], gf[ks], y[m]);
      }
      __builtin_amdgcn_sched_barrier(0);
      SSD_FRESH();
      {
        const int t = tbase + w * 16 + fr;
        const bool valid = t >= 0 && t < L;
        bf16_t* yrow = ZY + (size_t)(rowbase + (valid ? t : 0)) * DSSM + h * 64 + fq * 4;
        float part = 0.f;
#pragma unroll
        for (int m = 0; m < 4; ++m) {
          const float z0 = bflo(zc[m].x), z1 = bfhi(zc[m].x), z2 = bflo(zc[m].y), z3 = bfhi(zc[m].y);
          const float y0 = y[m][0] * siluf_(z0), y1 = y[m][1] * siluf_(z1), y2 = y[m][2] * siluf_(z2), y3 = y[m][3] * siluf_(z3);
          part += y0 * y0 + y1 * y1 + y2 * y2 + y3 * y3;
          uint2 pk; pk.x = pack2(y0, y1); pk.y = pack2(y2, y3);
          if (valid && !dry) *(uint2*)(yrow + m * 16) = pk;
        }
        part += __shfl_xor(part, 16); part += __shfl_xor(part, 32);
        if (fq == 0 && valid && !dry) WSF(p, ssq)[(size_t)(rowbase + t) * 32 + h] = part;
      }
    }
    if (active) {
      SSD_FRESH();
      {
        const float cd = __expf(s_acs[63]);
#pragma unroll
        for (int m = 0; m < 4; ++m)
#pragma unroll
          for (int nn = 0; nn < 2; ++nn) hacc[m][nn] *= cd;
#pragma unroll
        for (int ks = 0; ks < 2; ++ks) {
          if (samp && ks == 1) break;
          bf16x8 bfr[2];
          const f32x4 wt0 = *(const f32x4*)(s_wt + ks * 32 + fq * 8), wt1 = *(const f32x4*)(s_wt + ks * 32 + fq * 8 + 4);
#pragma unroll
          for (int nn = 0; nn < 2; ++nn) {
            unsigned pw[4];
#pragma unroll
            for (int jj = 0; jj < 8; jj += 2) {
              const int sidx = ks * 32 + fq * 8 + jj;
              const float b0 = bf2f(sB[sidx * LDN + w * 32 + nn * 16 + fr]) * (jj < 4 ? wt0[jj & 3] : wt1[jj & 3]);
              const float b1 = bf2f(sB[(sidx + 1) * LDN + w * 32 + nn * 16 + fr]) * (jj < 4 ? wt0[(jj + 1) & 3] : wt1[(jj + 1) & 3]);
              pw[jj >> 1] = pack2(b0, b1);
            }
            typedef unsigned u32x4_t __attribute__((ext_vector_type(4)));
            const u32x4_t pv = {pw[0], pw[1], pw[2], pw[3]};
            bfr[nn] = __builtin_bit_cast(bf16x8, pv);
          }
          bf16x8 af[4];
#pragma unroll
          for (int m = 0; m < 4; ++m) af[m] = *(const bf16x8*)(sXT + (m * 16 + fr) * LDQ + ks * 32 + fq * 8);
          __builtin_amdgcn_sched_barrier(0);
#pragma unroll
          for (int m = 0; m < 4; ++m)
#pragma unroll
            for (int nn = 0; nn < 2; ++nn) hacc[m][nn] = MFMA16(af[m], bfr[nn], hacc[m][nn]);
        }
      }
      if (samp && !dry) {
        float* st_out = p.out + OFF_SS + (size_t)(item0 + c) * 64 * 128;
#pragma unroll
        for (int m = 0; m < 4; ++m)
#pragma unroll
          for (int nn = 0; nn < 2; ++nn)
#pragma unroll
            for (int j = 0; j < 4; ++j) __builtin_nontemporal_store(hacc[m][nn][j], st_out + (m * 16 + fq * 4 + j) * 128 + w * 32 + nn * 16 + fr);
      }
    }
    if (samp && !active && !dry) ua_slice(p, (int)blockIdx.x * 17 + (c - 16), (int)gridDim.x * 17, tid);
    __syncthreads();
  }
  if (!samp && !dry) {
    float* st_out = p.out + OFF_PS + (size_t)item0 * 64 * 128;
#pragma unroll
    for (int m = 0; m < 4; ++m)
#pragma unroll
      for (int nn = 0; nn < 2; ++nn)
#pragma unroll
        for (int j = 0; j < 4; ++j) st_out[(m * 16 + fq * 4 + j) * 128 + w * 32 + nn * 16 + fr] = hacc[m][nn][j];
  }
  __builtin_amdgcn_s_setprio(0);
#undef SSD_PREFETCH
#undef SSD_FRESH
#undef SSD_STEP
}

DI void phase_elementwise(const Params& p) {
  const int tidq = opaque_tid();
  const int gt = blockIdx.x * NTHREADS + tidq, gn = gridDim.x * NTHREADS;
  bf16_t* Y = WSB(p, R0);
  const float* ssq = WSF(p, ssq);
  {
    const int cc = gt & 255, g = cc >> 6;
    constexpr int NI = MTOT;
    const int rstep = gn >> 8;
    for (int row0 = gt >> 8; row0 < NI; row0 += 4 * rstep) {
      uint4 u[4]; float4 s0[4], s1[4];
#pragma unroll
      for (int k = 0; k < 4; ++k) {
        const int row = row0 + k * rstep;
        if (row < NI) {
          u[k] = *(const uint4*)(Y + (size_t)row * DSSM + cc * 8);
          s0[k] = *(const float4*)(ssq + (size_t)row * 32 + g * 8); s1[k] = *(const float4*)(ssq + (size_t)row * 32 + g * 8 + 4);
        }
      }
#pragma unroll
      for (int k = 0; k < 4; ++k) {
        const int row = row0 + k * rstep;
        if (row < NI) {
          const float ss = s0[k].x + s0[k].y + s0[k].z + s0[k].w + s1[k].x + s1[k].y + s1[k].z + s1[k].w;
          const float rs = rsqrtf(ss * (1.f / 512.f) + EPS);
          uint4 o;
          o.x = pack2(bflo(u[k].x) * rs, bfhi(u[k].x) * rs);
          o.y = pack2(bflo(u[k].y) * rs, bfhi(u[k].y) * rs);
          o.z = pack2(bflo(u[k].z) * rs, bfhi(u[k].z) * rs);
          o.w = pack2(bflo(u[k].w) * rs, bfhi(u[k].w) * rs);
          *(uint4*)(Y + (size_t)row * DSSM + cc * 8) = o;
        }
      }
    }
  }
}

DI void phase_prep(const Params& p, char* smem) {
  const int tidq = opaque_tid();
  if (blockIdx.x == 0 && tidq < 4) ((int*)(p.ws + O_counter))[tidq] = 0;
  const int lane = tidq & 63, wid = tidq >> 6;
  bf16_t* XB = WSB(p, R1);
  for (int row0 = blockIdx.x * 8 + wid; row0 < MTOT; row0 += gridDim.x * 16) {
    float4 v[2][4];
#pragma unroll
    for (int q = 0; q < 2; ++q) {
      const int row = row0 + q * gridDim.x * 8;
      if (row < MTOT) {
        const float* xr = xrow_ptr(p.x_prompt, p.x_sample, p.meta, row);
#pragma unroll
        for (int i = 0; i < 4; ++i) v[q][i] = *(const float4*)(xr + i * 256 + lane * 4);
      }
    }
#pragma unroll
    for (int q = 0; q < 2; ++q) {
      const int row = row0 + q * gridDim.x * 8;
      float ss = 0.f;
      if (row < MTOT) {
#pragma unroll
        for (int i = 0; i < 4; ++i) {
          ss += v[q][i].x * v[q][i].x + v[q][i].y * v[q][i].y + v[q][i].z * v[q][i].z + v[q][i].w * v[q][i].w;
          uint2 o;
          o.x = pack2(v[q][i].x, v[q][i].y);
          o.y = pack2(v[q][i].z, v[q][i].w);
          *(uint2*)(XB + (size_t)row * DM + i * 256 + lane * 4) = o;
        }
      }
#pragma unroll
      for (int d = 1; d < 64; d <<= 1) ss += __shfl_xor(ss, d);
      if (lane == 0 && row < MTOT) WSF(p, ss0)[row] = ss;
    }
  }
  convert_weight(p.w_gu1, p.norm_ffn1, WSB(p, wt_gu1), DM, 2 * DFF, 2 * DFF, 1, smem, (int)blockIdx.x, (int)gridDim.x);
  convert_weight(p.w_in, p.norm_mix, WSB(p, wt_in), DM, 10272, NIN, 2, smem, (int)blockIdx.x, (int)gridDim.x, 0, (int)gridDim.x == 256 ? 408 : (1 << 30));
}

DI void convert_idle(const Params& p, char* smem, int which, int first, int count) {
  const int c = unit_c(smem);
  int rank = c - first, nr = count;
  if ((int)gridDim.x != 256) { rank = (int)blockIdx.x; nr = (int)gridDim.x; }
  else if (rank < 0 || rank >= count) return;
  if (which == 0) {
    convert_weight(p.w_down1, nullptr, WSB(p, wt_down1), DFF, DM, DM, 0, smem, rank, nr);
    if ((int)gridDim.x == 256) convert_weight(p.w_in, p.norm_mix, WSB(p, wt_in), DM, 10272, NIN, 2, smem, rank, nr, 408);
  }
  if (which == 1) {
    convert_weight(p.w_a_out, nullptr, WSB(p, wt_aout), DM, DM, DM, 0, smem, rank, nr);
    convert_weight(p.w_b_out, p.ssm_norm_w, WSB(p, wt_bout), DSSM, DM, DM, 0, smem, rank, nr);
    convert_weight(p.w_o, nullptr, WSB(p, wt_o), DM, DM, DM, 0, smem, rank, nr);
  }
  if (which == 2) convert_weight(p.w_gu2, p.norm_ffn2, WSB(p, wt_gu2), DM, 2 * DFF, 2 * DFF, 1, smem, rank, nr);
  if (which == 3) convert_weight(p.w_down2, nullptr, WSB(p, wt_down2), DFF, DM, DM, 0, smem, rank, nr);
}

DI void phase_final(const Params& p) {
  const int tidq = opaque_tid();
  const int lane = tidq & 63, wid = tidq >> 6;
  const int rstep = gridDim.x * 8;
  float4 wv[4];
#pragma unroll
  for (int i = 0; i < 4; ++i) wv[i] = *(const float4*)(p.norm_final + i * 256 + lane * 4);
  for (int row0 = blockIdx.x * 8 + wid; row0 < TAIL_ROW0; row0 += 2 * rstep) {
    float4 v[2][4]; float sp[2]; float* o[2];
#pragma unroll
    for (int q = 0; q < 2; ++q) {
      const int row = row0 + q * rstep;
      o[q] = nullptr; sp[q] = 0.f;
      if (row < TAIL_ROW0) {
        if (row < MP) {
          const int b = row / LP, t = row - b * LP;
          if (t >= 16) o[q] = p.out + OFF_YP + ((size_t)b * 2048 + (t - 16)) * DM;
        } else {
          o[q] = p.out + OFF_YS + (size_t)(row - MP) * DM;
        }
        if (o[q]) {
          if (lane < 16) sp[q] = WSF(p, ssp)[(size_t)row * 16 + lane];
#pragma unroll
          for (int i = 0; i < 4; ++i) v[q][i] = *(const float4*)(WSF(p, H) + (size_t)row * DM + i * 256 + lane * 4);
        }
      }
    }
#pragma unroll
    for (int q = 0; q < 2; ++q) {
      float s = sp[q];
      s += __shfl_xor(s, 1); s += __shfl_xor(s, 2); s += __shfl_xor(s, 4); s += __shfl_xor(s, 8);
      s = __shfl(s, 0);
      if (o[q]) {
        const float rs = rsqrtf(s * (1.f / DM) + EPS);
#pragma unroll
        for (int i = 0; i < 4; ++i) {
          float4 r;
          r.x = v[q][i].x * rs * wv[i].x; r.y = v[q][i].y * rs * wv[i].y; r.z = v[q][i].z * rs * wv[i].z; r.w = v[q][i].w * rs * wv[i].w;
          { const f32x4 rv = {r.x, r.y, r.z, r.w}; __builtin_nontemporal_store(rv, (f32x4*)(o[q] + i * 256 + lane * 4)); }
        }
      }
    }
  }
  {
    const float* slab = (const float*)WSB(p, XBC);
    for (int row = TAIL_ROW0 + blockIdx.x * 8 + wid; row < MTOT; row += gridDim.x * 8) {
      float* o = row < MP ? p.out + OFF_YP + ((size_t)(row / LP) * 2048 + (row % LP - 16)) * DM : p.out + OFF_YS + (size_t)(row - MP) * DM;
      f32x4 h[4];
      float ss = 0.f;
#pragma unroll
      for (int i = 0; i < 4; ++i) {
        const int col = i * 256 + lane * 4;
        f32x4 pv[11];
#pragma unroll
        for (int k = 0; k < 11; ++k) pv[k] = *(const f32x4*)(slab + ((size_t)k * 768 + (row - TAIL_ROW0)) * DM + col);
        f32x4 a = {0.f, 0.f, 0.f, 0.f};
#pragma unroll
        for (int k = 0; k < 11; ++k) a += pv[k];
        h[i] = *(const f32x4*)(WSF(p, H) + (size_t)row * DM + col) + a * 0.5f;
        ss += h[i][0] * h[i][0] + h[i][1] * h[i][1] + h[i][2] * h[i][2] + h[i][3] * h[i][3];
      }
#pragma unroll
      for (int d = 1; d < 64; d <<= 1) ss += __shfl_xor(ss, d);
      const float rs = rsqrtf(ss * (1.f / DM) + EPS);
#pragma unroll
      for (int i = 0; i < 4; ++i) {
        const f32x4 r = {h[i][0] * rs * wv[i].x, h[i][1] * rs * wv[i].y, h[i][2] * rs * wv[i].z, h[i][3] * rs * wv[i].w};
        *(f32x4*)(o + i * 256 + lane * 4) = r;
      }
    }
  }
}

typedef const __attribute__((address_space(4))) Params* KParamsPtr;
DI Params load_params() {
  KParamsPtr kp = (KParamsPtr)__builtin_amdgcn_kernarg_segment_ptr();
  asm volatile("" : "+s"(kp));
  Params q;
  q.x_prompt = kp->x_prompt; q.x_sample = kp->x_sample; q.st_conv_a = kp->st_conv_a; q.st_ssm_conv = kp->st_ssm_conv; q.st_ssm = kp->st_ssm; q.meta = kp->meta;
  q.norm_ffn1 = kp->norm_ffn1; q.w_gu1 = kp->w_gu1; q.w_down1 = kp->w_down1; q.norm_mix = kp->norm_mix; q.w_in = kp->w_in; q.conv_a_w = kp->conv_a_w;
  q.w_a_out = kp->w_a_out; q.ssm_conv_w = kp->ssm_conv_w; q.ssm_conv_b = kp->ssm_conv_b; q.dt_bias = kp->dt_bias; q.a_log = kp->a_log; q.d_skip = kp->d_skip;
  q.ssm_norm_w = kp->ssm_norm_w; q.w_b_out = kp->w_b_out; q.w_o = kp->w_o; q.norm_ffn2 = kp->norm_ffn2; q.w_gu2 = kp->w_gu2; q.w_down2 = kp->w_down2;
  q.norm_final = kp->norm_final; q.out = kp->out; q.ws = kp->ws;
  return q;
}

#ifndef PH_MASK
#define PH_MASK 0xFFFF
#endif
#ifndef REP_MASK
#define REP_MASK 0
#endif
#define PH(k) if constexpr ((PH_MASK >> (k)) & 1)
#define REP(k) for (int rep_ = (((REP_MASK >> (k)) & 1) ? 0 : 1); rep_ < 2; ++rep_)
#define GRID_BARRIER() do { const Params pb_ = load_params(); XcdBarrier xb_; xb_.bar = (unsigned*)(pb_.ws + O_bar); xb_.x = xb_xcc_id(); \
    xb_.st = (volatile LAS unsigned*)(smem + SITEM_OFF + 16); xcd_barrier(xb_); } while (0)
__global__ void __launch_bounds__(NTHREADS) hybrid_fwd(Params p_unused) {
  extern __shared__ __attribute__((aligned(16))) char smem[];
  cg::grid_group grid = cg::this_grid();
  unsigned* bar; { const Params p = load_params(); bar = (unsigned*)(p.ws + O_bar); }
  volatile LAS unsigned* xb_st = (volatile LAS unsigned*)(smem + SITEM_OFF + 16);
  int* s_c = (int*)(smem + SITEM_OFF + 32);
  if (threadIdx.x == 0) { xb_st[0] = 0u; xb_st[1] = 0u; }
  __syncthreads();
  { const XcdBarrier xb0 = xcd_barrier_post(bar, xb_st);
    if (threadIdx.x == 0) s_c[0] = (int)xb_add(&bar[XCD_BAR_WORDS + 64 * xb0.x], 1u); }
  REP(0) { PH(0) { const Params p = load_params(); phase_prep(p, smem); }
  GRID_BARRIER(); }
  if (bar == nullptr) grid.sync();
  if (threadIdx.x == 0) {
    bool even = (gridDim.x & 7) == 0;
    for (unsigned j = 0; j < 8; ++j) even = even && (xb_ld(&bar[XCD_BAR_WORDS + 64 * j]) == gridDim.x / 8);
    s_c[1] = even ? (int)(xb_xcc_id() + 8u * (unsigned)s_c[0]) : (int)blockIdx.x;
  }
  __syncthreads();
  REP(1) { PH(1) { const Params p = load_params(); {
    pg8::EpiSwiglu<1> E{WSB(p, R0), WSF(p, ss0)};
    run_gemm(smem, WSB(p, R1), WSB(p, wt_gu1), 2 * DFF, DM, E);
    convert_idle(p, smem, 0, 194, 62);
  } }
  GRID_BARRIER(); }
  PH(2) { const Params p = load_params();
    pg8::EpiDown E{p.x_prompt, p.x_sample, p.meta, WSF(p, H), 1, 0.5f, WSB(p, R1), WSF(p, ssp)};
    run_gemm_panel(smem, WSB(p, R0), WSB(p, wt_down1), DM, DFF, E);
    run_gemm_tail(smem, WSB(p, R0), WSB(p, wt_down1), DM, DFF, 11, (float*)WSB(p, XBC));
    convert_idle(p, smem, 1, 132, 124);
  }
  GRID_BARRIER();
  PH(2) { const Params p = load_params(); fixup_down<11>(p, true, 0.5f, WSB(p, R1)); }
  GRID_BARRIER();
  REP(3) { PH(3) { const Params p = load_params(); {
    pg8::EpiInproj E{WSF(p, rsv), p.out, p.ws, p.dt_bias};
    run_gemm(smem, WSB(p, R1), WSB(p, wt_in), NIN, DM, E);
    convert_idle(p, smem, 2, 187, 69);
  } }
  GRID_BARRIER(); }
  PH(11) { const Params p = load_params(); phase_conv(p); }
  GRID_BARRIER();
  REP(4) { PH(4) { const Params p = load_params(); { int dry = (rep_ == 0); asm volatile("" : "+s"(dry)); phase_ssd(p, smem, dry); } }
  GRID_BARRIER(); }
  PH(5) { const Params p = load_params(); phase_elementwise(p); }
  GRID_BARRIER();
  PH(6) { const Params p = load_params();
    pg8::EpiGate<false> E1{WSB(p, AB), WSB(p, SGA)};
    run_gemm_panel(smem, WSB(p, R1), WSB(p, wt_aout), DM, DM, E1);
    pg8::EpiGate<true> E2{WSB(p, AB), WSB(p, SGB)};
    run_gemm_panel(smem, WSB(p, R0), WSB(p, wt_bout), DM, DSSM, E2);
    run_gemm_tail(smem, WSB(p, R1), WSB(p, wt_aout), DM, DM, 4, (float*)WSB(p, XBC), 96);
    run_gemm_tail(smem, WSB(p, R0), WSB(p, wt_bout), DM, DSSM, 8, (float*)WSB(p, XBC) + (size_t)4 * 768 * DM);
  }
  GRID_BARRIER();
  PH(6) { const Params p = load_params(); fixup_merge(p); }
  GRID_BARRIER();
  PH(7) { const Params p = load_params();
    pg8::EpiDown E{p.x_prompt, p.x_sample, p.meta, WSF(p, H), 0, 1.0f, WSB(p, R1), WSF(p, ssp)};
    run_gemm_panel(smem, WSB(p, AB), WSB(p, wt_o), DM, DM, E);
    run_gemm_tail(smem, WSB(p, AB), WSB(p, wt_o), DM, DM, 4, (float*)WSB(p, XBC));
  }
  GRID_BARRIER();
  PH(7) { const Params p = load_params(); fixup_down<4>(p, false, 1.0f, WSB(p, R1)); }
  GRID_BARRIER();
  REP(8) { PH(8) { const Params p = load_params(); {
    pg8::EpiSwiglu<0> E{WSB(p, R0), WSF(p, rsv)};
    run_gemm(smem, WSB(p, R1), WSB(p, wt_gu2), 2 * DFF, DM, E);
    convert_idle(p, smem, 3, 194, 62);
  } }
  GRID_BARRIER(); }
  PH(9) { const Params p = load_params();
    pg8::EpiDown E{p.x_prompt, p.x_sample, p.meta, WSF(p, H), 0, 0.5f, nullptr, WSF(p, ssp)};
    run_gemm_panel(smem, WSB(p, R0), WSB(p, wt_down2), DM, DFF, E);
    run_gemm_tail(smem, WSB(p, R0), WSB(p, wt_down2), DM, DFF, 11, (float*)WSB(p, XBC));
  }
  GRID_BARRIER();
  REP(10) { PH(10) { const Params p = load_params(); phase_final(p); } if (rep_ == 0) GRID_BARRIER(); }
}

extern "C" void kernel_launch(void* const* d_in, const int* in_sizes, int n_in, void* d_out, int out_size, void* d_ws, size_t ws_size,
                              hipStream_t stream) {
  static int grid_blocks = 0;
  if (!grid_blocks) {
    int dev = 0, cus = 0, per_cu = 0;
    (void)hipGetDevice(&dev);
    (void)hipDeviceGetAttribute(&cus, hipDeviceAttributeMultiprocessorCount, dev);
    (void)hipFuncSetAttribute((const void*)hybrid_fwd, hipFuncAttributeMaxDynamicSharedMemorySize, LDS_BYTES);
    (void)hipOccupancyMaxActiveBlocksPerMultiprocessor(&per_cu, (const void*)hybrid_fwd, NTHREADS, LDS_BYTES);
    if (per_cu < 1) { fprintf(stderr, "kernel_launch: occupancy query reports %d blocks per CU\n", per_cu); per_cu = 1; }
    grid_blocks = 256;
    if (cus < 256) fprintf(stderr, "kernel_launch: %d CUs < 256: the cooperative launch will be refused\n", cus);
    fprintf(stderr, "kernel_launch: cus=%d per_cu=%d grid=%d ws=%zu\n", cus, per_cu, grid_blocks, ws_size);
  }
  Params p{};
  const float* const* in = (const float* const*)d_in;
  p.x_prompt = in[0]; p.x_sample = in[1]; p.st_conv_a = in[2]; p.st_ssm_conv = in[3]; p.st_ssm = in[4]; p.meta = in[5];
  p.norm_ffn1 = in[6]; p.w_gu1 = in[7]; p.w_down1 = in[8]; p.norm_mix = in[9]; p.w_in = in[10]; p.conv_a_w = in[11];
  p.w_a_out = in[12]; p.ssm_conv_w = in[13]; p.ssm_conv_b = in[14]; p.dt_bias = in[15]; p.a_log = in[16]; p.d_skip = in[17];
  p.ssm_norm_w = in[18]; p.w_b_out = in[19]; p.w_o = in[20]; p.norm_ffn2 = in[21]; p.w_gu2 = in[22]; p.w_down2 = in[23];
  p.norm_final = in[24];
  p.out = (float*)d_out;
  p.ws = (char*)d_ws;
  if (WS_END > ws_size) { fprintf(stderr, "kernel_launch: workspace too small: need %zu have %zu\n", (size_t)WS_END, ws_size); return; }
  (void)hipMemsetAsync((char*)d_ws + O_bar, 0, BAR_BYTES, stream);
  void* args[] = {&p};
  hipError_t e = hipLaunchCooperativeKernel((const void*)hybrid_fwd, dim3(grid_blocks), dim3(NTHREADS), args, LDS_BYTES, stream);
  if (e != hipSuccess) fprintf(stderr, "cooperative launch failed: %s (grid %d)\n", hipGetErrorString(e), grid_blocks);
}
```
